# Optimizing an MI355X kernel written in HIP

```python
import math
import jax, jax.numpy as jnp
from jax import lax
import numpy as np

D_MODEL = 1024
BATCH = 4
SEQ = 8192
DEPTH = 4

GRID_W = 64
CTX_LEN = 256
N_MIXERS = 2
S5_GROUP = 16
S5_GROUPS = D_MODEL // S5_GROUP
S5_STATE = 64
POOL_WINDOWS = (2, 4, 8, 16)
POOL_GROUPS = len(POOL_WINDOWS)
POOL_CH = D_MODEL // POOL_GROUPS
D_FF = 4 * D_MODEL
N_S5 = (DEPTH + N_MIXERS - 1) // N_MIXERS
N_POOL = DEPTH // N_MIXERS
DT_MIN = 1e-3
DT_MAX = 1e-1
EPS = 1e-6

kernel_name = "hybrid_s5_pool_prefix_dit"


def _rmsnorm(x, g):
    xf = x.astype(jnp.float32)
    y = xf * lax.rsqrt(jnp.mean(xf * xf, axis=-1, keepdims=True) + EPS)
    return (y * g.astype(jnp.float32)).astype(x.dtype)


def _modulate(h, shift, scale):
    return h * (1 + scale) + shift


def _mlp(h, w1, b1, w2, b2):
    a = jax.nn.relu(h @ w1 + b1)
    return (a * a) @ w2 + b2


def _s5_discretize(a_re, a_im, log_dt, b_re, b_im):
    f = jnp.float32
    a_re, a_im, b_re, b_im = a_re.astype(f), a_im.astype(f), b_re.astype(f), b_im.astype(f)
    dt = jnp.exp(log_dt.astype(f))[:, None]
    da_re, da_im = a_re * dt, a_im * dt
    mag = jnp.exp(da_re)
    lb_re, lb_im = mag * jnp.cos(da_im), mag * jnp.sin(da_im)
    den = a_re * a_re + a_im * a_im
    num_re, num_im = lb_re - 1.0, lb_im
    k_re = (num_re * a_re + num_im * a_im) / den
    k_im = (num_im * a_re - num_re * a_im) / den
    bb_re = k_re[..., None] * b_re - k_im[..., None] * b_im
    bb_im = k_re[..., None] * b_im + k_im[..., None] * b_re
    return lb_re, lb_im, da_re, da_im, bb_re, bb_im


def _apply_b(ug, bb_re, bb_im):
    return (jnp.einsum('blgh,gph->blgp', ug, bb_re),
            jnp.einsum('blgh,gph->blgp', ug, bb_im))


def _diag_scan(bu_re, bu_im, da_re, da_im, reverse):
    def combine(a, b):
        n1, r1, i1 = a
        n2, r2, i2 = b
        mag = jnp.exp(n2 * da_re)
        ang = n2 * da_im
        p_re, p_im = mag * jnp.cos(ang), mag * jnp.sin(ang)
        return (n1 + n2, p_re * r1 - p_im * i1 + r2, p_re * i1 + p_im * r1 + i2)
    n = jnp.ones((1, bu_re.shape[1], 1, 1), jnp.float32)
    _, h_re, h_im = lax.associative_scan(combine, (n, bu_re, bu_im), reverse=reverse, axis=1)
    return h_re, h_im


def _readout(h_re, h_im, c_re, c_im):
    f = jnp.float32
    return (jnp.einsum('blgp,ghp->blgh', h_re, c_re.astype(f))
            - jnp.einsum('blgp,ghp->blgh', h_im, c_im.astype(f)))


def _s5_mixer(u, uc, a_re, a_im, log_dt, b_re, b_im, c_re, c_im, d_skip, glu_w, glu_b, ctx_out):
    f = jnp.float32
    bsz, n_lat, _ = u.shape
    n_ctx = uc.shape[1]
    ug = u.astype(f).reshape(bsz, n_lat, S5_GROUPS, S5_GROUP)
    ucg = uc.astype(f).reshape(bsz, n_ctx, S5_GROUPS, S5_GROUP)
    y = jnp.zeros_like(ug)
    yc = jnp.zeros_like(ucg) if ctx_out else None
    for d in range(2):
        rev = d == 1
        lb_re, lb_im, da_re, da_im, bb_re, bb_im = _s5_discretize(
            a_re[d], a_im[d], log_dt[d], b_re[d], b_im[d])
        cu_re, cu_im = _apply_b(ucg, bb_re, bb_im)
        hc_re, hc_im = _diag_scan(cu_re, cu_im, da_re, da_im, rev)
        end = 0 if rev else -1
        h0_re, h0_im = hc_re[:, end], hc_im[:, end]
        if ctx_out:
            yc = yc + _readout(hc_re, hc_im, c_re[d], c_im[d])
        lu_re, lu_im = _apply_b(ug, bb_re, bb_im)
        start = -1 if rev else 0
        lu_re = lu_re.at[:, start].add(lb_re * h0_re - lb_im * h0_im)
        lu_im = lu_im.at[:, start].add(lb_re * h0_im + lb_im * h0_re)
        h_re, h_im = _diag_scan(lu_re, lu_im, da_re, da_im, rev)
        y = y + _readout(h_re, h_im, c_re[d], c_im[d])

    def post(yy, uu):
        out = yy.reshape(uu.shape) + d_skip.astype(f) * uu.astype(f)
        z = jax.nn.gelu(out).astype(uu.dtype)
        return z * jax.nn.sigmoid(z @ glu_w + glu_b)

    return post(y, u), (post(yc, uc) if ctx_out else None)


def _window_bounds(n, w):
    t = jnp.arange(n)
    return jnp.maximum(t - w // 2, 0), jnp.minimum(t + w - w // 2, n)


def _pool_grid(xg, w, rows):
    b, n, ch = xg.shape
    g = xg.reshape(b, rows, GRID_W, ch)
    s = jnp.cumsum(jnp.cumsum(g, axis=1), axis=2)
    s = jnp.pad(s, ((0, 0), (1, 0), (1, 0), (0, 0)))
    r_lo, r_hi = _window_bounds(rows, w)
    c_lo, c_hi = _window_bounds(GRID_W, w)
    s_hi = jnp.take(s, r_hi, axis=1)
    s_lo = jnp.take(s, r_lo, axis=1)
    tot = (jnp.take(s_hi, c_hi, axis=2) - jnp.take(s_hi, c_lo, axis=2)
           - jnp.take(s_lo, c_hi, axis=2) + jnp.take(s_lo, c_lo, axis=2))
    cnt = ((r_hi - r_lo)[:, None] * (c_hi - c_lo)[None, :]).astype(jnp.float32)
    return (tot / cnt[None, :, :, None] - g).reshape(b, n, ch)


def _pool_seq(xs, w):
    n = xs.shape[1]
    s = jnp.pad(jnp.cumsum(xs, axis=1), ((0, 0), (1, 0), (0, 0)))
    lo, hi = _window_bounds(n, w)
    cnt = (hi - lo).astype(jnp.float32)[None, :, None]
    return (jnp.take(s, hi, axis=1) - jnp.take(s, lo, axis=1)) / cnt - xs


def _pool_mixer(u, pool_w, pool_scale, rows):
    uf = u.astype(jnp.float32)
    parts = []
    for gi, w in enumerate(POOL_WINDOWS):
        xg = uf[..., gi * POOL_CH:(gi + 1) * POOL_CH]
        parts.append(_pool_grid(xg, w, rows) if rows is not None else _pool_seq(xg, w))
    p = jnp.stack(parts, axis=2).astype(u.dtype)
    y = jnp.einsum('blgc,gcd->blgd', p, pool_w).reshape(u.shape)
    return y * pool_scale


def setup_inputs(seed: int = 0) -> dict:
    key = jax.random.key(seed)
    ks = jax.random.split(key, 32)
    f = jnp.float32
    G, P, H, D = S5_GROUPS, S5_STATE, S5_GROUP, D_MODEL

    def nrm(k, shape, s):
        return jax.random.normal(k, shape, f) * s

    n_idx = jnp.arange(P, dtype=f)
    return {
        "x": nrm(ks[0], (BATCH, SEQ, D), 1.0),
        "c": nrm(ks[1], (BATCH, D), 1.0),
        "ctx": nrm(ks[2], (BATCH, CTX_LEN, D), 1.0),
        "c_ctx": nrm(ks[3], (D,), 1.0),
        "ada_w": nrm(ks[4], (DEPTH, D, 6 * D), 0.5 * D ** -0.5),
        "ada_b": nrm(ks[5], (DEPTH, 6 * D), 0.02),
        "norm1_g": 1.0 + nrm(ks[6], (DEPTH, D), 0.05),
        "norm2_g": 1.0 + nrm(ks[7], (DEPTH, D), 0.05),
        "s5_a_re": -0.5 + nrm(ks[8], (N_S5, 2, G, P), 0.02),
        "s5_a_im": math.pi * n_idx + nrm(ks[9], (N_S5, 2, G, P), 0.02),
        "s5_log_dt": jax.random.uniform(ks[10], (N_S5, 2, G), f,
                                         math.log(DT_MIN), math.log(DT_MAX)),
        "s5_b_re": nrm(ks[11], (N_S5, 2, G, P, H), H ** -0.5),
        "s5_b_im": nrm(ks[12], (N_S5, 2, G, P, H), H ** -0.5),
        "s5_c_re": nrm(ks[13], (N_S5, 2, G, H, P), P ** -0.5),
        "s5_c_im": nrm(ks[14], (N_S5, 2, G, H, P), P ** -0.5),
        "s5_d": nrm(ks[15], (N_S5, D), 1.0),
        "s5_glu_w": nrm(ks[16], (N_S5, D, D), D ** -0.5),
        "s5_glu_b": nrm(ks[17], (N_S5, D), 0.02),
        "pool_w": nrm(ks[18], (N_POOL, POOL_GROUPS, POOL_CH, POOL_CH), POOL_CH ** -0.5),
        "pool_scale": 1.0 + nrm(ks[19], (N_POOL, D), 0.05),
        "mlp_w1": nrm(ks[20], (DEPTH, D, D_FF), D ** -0.5),
        "mlp_b1": nrm(ks[21], (DEPTH, D_FF), 0.02),
        "mlp_w2": nrm(ks[22], (DEPTH, D_FF, D), D_FF ** -0.5),
        "mlp_b2": nrm(ks[23], (DEPTH, D), 0.02),
        "final_g": 1.0 + nrm(ks[24], (D,), 0.05),
    }


def reference(x, c, ctx, c_ctx, ada_w, ada_b, norm1_g, norm2_g,
              s5_a_re, s5_a_im, s5_log_dt, s5_b_re, s5_b_im, s5_c_re, s5_c_im,
              s5_d, s5_glu_w, s5_glu_b, pool_w, pool_scale,
              mlp_w1, mlp_b1, mlp_w2, mlp_b2, final_g):
    n_tok = x.shape[1]
    rows = n_tok // GRID_W
    last_ctx_reader = ((DEPTH - 1) // N_MIXERS) * N_MIXERS
    silu_c = jax.nn.silu(c)
    silu_cc = jax.nn.silu(c_ctx)
    h_ctx = ctx
    for i in range(DEPTH):
        ctx_in = i <= last_ctx_reader
        ctx_out = i < last_ctx_reader
        j = i // N_MIXERS
        mod = silu_c @ ada_w[i] + ada_b[i]
        sh1, sc1, g1, sh2, sc2, g2 = jnp.split(mod[:, None, :], 6, axis=-1)
        xn = _modulate(_rmsnorm(x, norm1_g[i]), sh1, sc1)
        if ctx_in:
            mod_c = silu_cc @ ada_w[i] + ada_b[i]
            csh1, csc1, cg1, csh2, csc2, cg2 = jnp.split(mod_c, 6)
            cn = _modulate(_rmsnorm(h_ctx, norm1_g[i]), csh1, csc1)
        if i % N_MIXERS == 0:
            y, yc = _s5_mixer(xn, cn, s5_a_re[j], s5_a_im[j], s5_log_dt[j],
                              s5_b_re[j], s5_b_im[j], s5_c_re[j], s5_c_im[j],
                              s5_d[j], s5_glu_w[j], s5_glu_b[j], ctx_out)
        else:
            y = _pool_mixer(xn, pool_w[j], pool_scale[j], rows)
            yc = _pool_mixer(cn, pool_w[j], pool_scale[j], None) if ctx_out else None
        x = x + g1 * y
        x = x + g2 * _mlp(_modulate(_rmsnorm(x, norm2_g[i]), sh2, sc2),
                          mlp_w1[i], mlp_b1[i], mlp_w2[i], mlp_b2[i])
        if ctx_out:
            h_ctx = h_ctx + cg1 * yc
            h_ctx = h_ctx + cg2 * _mlp(_modulate(_rmsnorm(h_ctx, norm2_g[i]), csh2, csc2),
                                       mlp_w1[i], mlp_b1[i], mlp_w2[i], mlp_b2[i])
    return _rmsnorm(x, final_g)
```

```cpp
#include <hip/hip_runtime.h>
#include <hip/hip_cooperative_groups.h>
#include <cstdio>
namespace cg = cooperative_groups;

#define LAS __attribute__((address_space(3)))
typedef unsigned short bf16_t;
typedef short bf16x8 __attribute__((ext_vector_type(8)));
typedef float f32x4 __attribute__((ext_vector_type(4)));
typedef unsigned u32x4 __attribute__((ext_vector_type(4)));
typedef unsigned u32x2 __attribute__((ext_vector_type(2)));

constexpr int D = 1024, NLAT = 32768, NROW = 33792, DFF = 4096;
constexpr int CRR = 1056, CR_PAD = 1280, XS_K = 768;
constexpr int LDS_BYTES = 147456;

constexpr size_t OFF_W1 = 0;
constexpr size_t OFF_W2 = OFF_W1 + 33554432;
constexpr size_t OFF_WG = OFF_W2 + 33554432;
constexpr size_t OFF_WP = OFF_WG + 4194304;
constexpr size_t OFF_MOD = OFF_WP + 1048576;
constexpr size_t OFF_XC = OFF_MOD + 491520;
constexpr size_t OFF_XN = OFF_XC + 4194304;
constexpr size_t OFF_Z = OFF_XN + 69206016;
constexpr size_t OFF_ACT = OFF_Z + 69206016;
constexpr size_t OFF_MTAB = OFF_ACT + 276824064;
constexpr size_t OFF_BAR = OFF_MTAB + 8388608;
constexpr size_t WS_END = OFF_BAR + 16384;
constexpr size_t OFF_TC = OFF_ACT;
constexpr size_t OFF_SM = OFF_TC + 50331648;
constexpr size_t OFF_SL = OFF_SM + 16777216;
constexpr size_t OFF_XS = OFF_SL + 83886080;

struct Params {
    const float *x, *c, *ctx, *c_ctx, *ada_w, *ada_b, *norm1_g, *norm2_g, *a_re, *a_im, *log_dt, *b_re, *b_im, *c_re, *c_im, *s5_d, *glu_w, *glu_b,
        *pool_w, *pool_scale, *w1, *b1, *w2, *b2, *final_g;
    float* out;
    unsigned char* ws;
};

__device__ __forceinline__ unsigned pk2(float lo, float hi) { unsigned r; asm("v_cvt_pk_bf16_f32 %0, %1, %2" : "=v"(r) : "v"(lo), "v"(hi)); return r; }
__device__ __forceinline__ float bflo(unsigned w) { return __uint_as_float(w << 16); }
__device__ __forceinline__ float bfhi(unsigned w) { return __uint_as_float(w & 0xffff0000u); }
__device__ __forceinline__ float wave_sum(float v) {
#pragma unroll
    for (int o = 1; o < 64; o <<= 1) v += __shfl_xor(v, o);
    return v;
}
__device__ __forceinline__ float fast_exp(float x) { return __builtin_amdgcn_exp2f(x * 1.4426950408889634f); }
__device__ __forceinline__ float fast_sigmoid(float x) { return __builtin_amdgcn_rcpf(1.0f + fast_exp(-x)); }
__device__ __forceinline__ float gelu_tanh(float v) {
    const float inner = 1.5957691216057308f * (v + 0.044715f * v * v * v);
    return v * fast_sigmoid(inner);
}
__device__ __forceinline__ void cpowk(float dar, float dai, int k, float& re, float& im) {
    const float mag = fast_exp((float)k * dar);
    double rv = (double)k * (double)dai * 0.15915494309189535; rv -= __builtin_rint(rv);
    const float fr = (float)rv;
    re = mag * __builtin_amdgcn_cosf(fr); im = mag * __builtin_amdgcn_sinf(fr);
}


#define XB_TMO      128
#define XB_XCNT(j)  (256  + 64 * (j))
#define XB_XSUB(j)  (1280 + 64 * (j))
#define XB_XGEN(j)  (2304 + 64 * (j))
#define XB_TOP      3328
#define XB_TOPGEN   3392
#define XCD_BAR_WORDS 3456
#define XB_SPIN_CAP (1u << 22)
__device__ __forceinline__ unsigned xb_ld(unsigned* p)              { return __hip_atomic_load(p, __ATOMIC_RELAXED, __HIP_MEMORY_SCOPE_AGENT); }
__device__ __forceinline__ unsigned xb_add(unsigned* p, unsigned v) { return __hip_atomic_fetch_add(p, v, __ATOMIC_RELAXED, __HIP_MEMORY_SCOPE_AGENT); }
__device__ __forceinline__ unsigned xb_xcc_id() { return (unsigned)__builtin_amdgcn_s_getreg((3 << 11) | 20) & 0xFu; }
#define XB_SPIN(cond, bar) do { unsigned _sp = 0; while (cond) { __builtin_amdgcn_s_sleep(1); \
    if ((++_sp & 255u) == 0u) { if (xb_ld(&(bar)[XB_TMO])) break; if (_sp > XB_SPIN_CAP) { atomicAdd(&(bar)[XB_TMO], 1u); break; } } } } while (0)
struct XcdBarrier { unsigned* bar; unsigned x; volatile LAS unsigned* st; };
__device__ __forceinline__ XcdBarrier xcd_barrier_post(unsigned* bar, volatile LAS unsigned* st) {
    XcdBarrier b; b.bar = bar; b.x = xb_xcc_id(); b.st = st;
    if (threadIdx.x == 0) (void)xb_add(&bar[XB_XCNT(b.x)], 1u);
    return b;
}
__device__ __forceinline__ void xcd_barrier_complete(unsigned* bar, unsigned x, unsigned& nloc, unsigned& nx) {
    const unsigned G = gridDim.x * gridDim.y * gridDim.z;
    unsigned sum, cnt, mine, sp = 0u;
    for (;;) {
        sum = 0u; cnt = 0u; mine = 0u;
#pragma unroll
        for (unsigned j = 0; j < 16; ++j) { const unsigned c = xb_ld(&bar[XB_XCNT(j)]); sum += c; cnt += (c > 0u) ? 1u : 0u; mine = (j == x) ? c : mine; }
        if (sum == G) break;
        __builtin_amdgcn_s_sleep(1);
        if ((++sp & 255u) == 0u) { if (xb_ld(&bar[XB_TMO])) break; if (sp > XB_SPIN_CAP) { atomicAdd(&bar[XB_TMO], 1u); break; } }
    }
    nloc = mine > 0u ? mine : 1u; nx = cnt > 0u ? cnt : 1u;
}
__device__ __forceinline__ void xcd_barrier(const XcdBarrier& b) {
    asm volatile("s_waitcnt vmcnt(0)" ::: "memory");
    __syncthreads();
    if (threadIdx.x == 0) {
        unsigned* bar = b.bar;
        __builtin_amdgcn_s_waitcnt(0);
        unsigned nloc = b.st[0], nx = b.st[1];
        if (nloc == 0u) { xcd_barrier_complete(bar, b.x, nloc, nx); b.st[0] = nloc; b.st[1] = nx; }
        const unsigned old = xb_add(&bar[XB_XSUB(b.x)], 1u);
        const unsigned gen = old / nloc;
        if (old + 1u == (gen + 1u) * nloc) {
            __builtin_amdgcn_fence(__ATOMIC_RELEASE, "agent");
            asm volatile("s_waitcnt vmcnt(0)" ::: "memory");
            const unsigned og = xb_add(&bar[XB_TOP], 1u);
            const unsigned tg = og / nx;
            if (og + 1u == (tg + 1u) * nx) xb_add(&bar[XB_TOPGEN], 1u);
            else XB_SPIN(xb_ld(&bar[XB_TOPGEN]) == tg, bar);
            __builtin_amdgcn_fence(__ATOMIC_ACQUIRE, "agent");
            xb_add(&bar[XB_XGEN(b.x)], 1u);
            asm volatile("s_waitcnt vmcnt(0)" ::: "memory");
        } else {
            XB_SPIN(xb_ld(&bar[XB_XGEN(b.x)]) == gen, bar);
            __builtin_amdgcn_fence(__ATOMIC_ACQUIRE, "agent");
            asm volatile("s_waitcnt vmcnt(0)" ::: "memory");
        }
    }
    __syncthreads();
}

namespace pg8 {
constexpr int BM = 256, BK = 64, HALF = 128, HTB = HALF * BK * 2, NXCD = 8, WGM = 8;
__device__ __forceinline__ int lds_byte(int r, int c) { const int st = (r >> 4) * 2 + (c >> 5), rr = r & 15, cc = c & 31, ob = rr * 64 + cc * 2; return st * 1024 + (ob ^ (((ob >> 9) & 1) << 5)); }
__device__ __forceinline__ void stage_rc(int b, int& R, int& C) { const int st = b / 1024, sb = b % 1024, swz = sb ^ (((sb >> 9) & 1) << 5); R = (st >> 1) * 16 + swz / 64; C = (st & 1) * 32 + (swz % 64) / 2; }
__device__ __forceinline__ int perm32(int rho) { const int n = rho >> 4, i = rho & 15; return 8 * (i >> 2) + 4 * n + (i & 3); }

struct Unit { int pm, pn, grp; };
struct Gemm { const bf16_t* A; const bf16_t* Bt; int lda, K; long a_gs, b_gs; int a_gm; };

struct Sched {
    int nM, nN, nwg, nG, G, c;
    __device__ __forceinline__ void init(int nM_, int nN_, int nG_, int G_, int c_) { nM = nM_; nN = nN_; nwg = nM_ * nN_; nG = nG_; G = G_; c = c_; }
    __device__ __forceinline__ bool next(int i, Unit& u) const {
        const long L = (long)i * G + c; if (L >= (long)nwg * nG) return false;
        u.grp = (int)(L / nwg); int wgid = (int)(L % nwg);
        { const int q = nwg / NXCD, r = nwg % NXCD, xcd = wgid % NXCD, off = wgid / NXCD; wgid = (xcd < r ? xcd * (q + 1) : r * (q + 1) + (xcd - r) * q) + off; }
        const int nig = WGM * nN, gid = wgid / nig, fm = gid * WGM, gsz = (nM - fm) < WGM ? (nM - fm) : WGM;
        u.pm = fm + ((wgid % nig) % gsz); u.pn = (wgid % nig) / gsz; return true;
    }
};

__device__ __forceinline__ void zero4(f32x4& v) { float a, b, c, d; asm volatile("v_mov_b32 %0, 0\n\tv_mov_b32 %1, 0\n\tv_mov_b32 %2, 0\n\tv_mov_b32 %3, 0" : "=v"(a), "=v"(b), "=v"(c), "=v"(d)); v = (f32x4){a, b, c, d}; }
template <class Epi>
__device__ __forceinline__ void gemm_phase(LAS unsigned char* lds, const Gemm g, const Sched& S, const Epi& E) {
    int tid = threadIdx.x; asm volatile("" : "+v"(tid));
    const int wid = __builtin_amdgcn_readfirstlane(tid >> 6), lane = tid & 63, wr = wid >> 2, wc = wid & 3, fr = lane & 15, fq = lane >> 4;
    int K = g.K, lda = g.lda; asm volatile("" : "+s"(K), "+s"(lda));
    const int nt = K / BK;
    unsigned voffA[2], voffB[2];
#pragma unroll
    for (int i = 0; i < 2; ++i) { int R, C; stage_rc(tid * 16 + i * 8192, R, C); const int Rb = Epi::PERM ? ((R & ~31) + perm32(R & 31)) : R;
        voffA[i] = g.a_gm ? (unsigned)(((C >> 4) * g.a_gm + R) * 16 + (C & 15)) * 2u : (unsigned)(R * lda + C) * 2u; voffB[i] = (unsigned)(Rb * K + C) * 2u; }
    const size_t kstep = (size_t)(BK * 2);
    const size_t kstepA = g.a_gm ? (size_t)g.a_gm * 128 : kstep;
    const size_t hstepA = g.a_gm ? (size_t)HALF * 32 : (size_t)HALF * lda * 2, hstepB = (size_t)HALF * K * 2;
    const size_t tstepA = 2 * hstepA, tstepB = 2 * hstepB;
    const unsigned ldsw = (unsigned)wid * 1024u;
    const int aoff = lds_byte(wr * 64 + fr, fq * 8), boff = lds_byte(wc * 32 + fr, fq * 8);
#define PG8_SA(b, h) (((b) * 2 + (h)) * HTB)
#define PG8_SB(b, h) ((4 + (b) * 2 + (h)) * HTB)
#define PG8_STAGE(bufoff, gbase, voff) do { _Pragma("unroll") for (int _i = 0; _i < 2; ++_i) \
        __builtin_amdgcn_global_load_lds((const unsigned*)((const char*)(gbase) + (voff)[_i]), (LAS unsigned*)(lds + (bufoff) + ldsw + _i * 8192), 16, 0, 0); } while (0)
#define PG8_LDA(dst, b, h) do { _Pragma("unroll") for (int m = 0; m < 4; ++m) _Pragma("unroll") for (int k = 0; k < 2; ++k) dst[m][k] = *(const LAS bf16x8*)(lds + PG8_SA(b, h) + aoff + m * 2048 + k * 1024); } while (0)
#define PG8_LDB(dst, b, h) do { _Pragma("unroll") for (int n = 0; n < 2; ++n) _Pragma("unroll") for (int k = 0; k < 2; ++k) dst[n][k] = *(const LAS bf16x8*)(lds + PG8_SB(b, h) + boff + n * 2048 + k * 1024); } while (0)
#define PG8_MMA(ai, bj, At, Bt) do { __builtin_amdgcn_s_setprio(1); _Pragma("unroll") for (int m = 0; m < 4; ++m) _Pragma("unroll") for (int n = 0; n < 2; ++n) _Pragma("unroll") for (int k = 0; k < 2; ++k) \
        acc[ai][bj][m][n] = __builtin_amdgcn_mfma_f32_16x16x32_bf16(Bt[n][k], At[m][k], acc[ai][bj][m][n], 0, 0, 0); __builtin_amdgcn_s_setprio(0); } while (0)
#define PG8_WAIT_V(n) asm volatile("s_waitcnt vmcnt(" #n ")" ::: "memory")
#define PG8_WAIT_L(n) asm volatile("s_waitcnt lgkmcnt(" #n ")" ::: "memory")
#define PG8_BAR __builtin_amdgcn_s_barrier()
#define PG8_SCHED __builtin_amdgcn_sched_barrier(0)
    Unit cur, nxt; int ui = 0;
    if (!S.next(0, cur)) return;
    f32x4 acc[2][2][4][2];
#pragma unroll
    for (int a = 0; a < 2; ++a)
#pragma unroll
        for (int b = 0; b < 2; ++b)
#pragma unroll
            for (int m = 0; m < 4; ++m)
#pragma unroll
                for (int n = 0; n < 2; ++n) zero4(acc[a][b][m][n]);
    bf16x8 At[4][2], B0[2][2], B1[2][2];
    const char* cA = (const char*)(g.A + (size_t)cur.grp * g.a_gs) + (size_t)cur.pm * tstepA;
    const char* cB = (const char*)(g.Bt + (size_t)cur.grp * g.b_gs) + (size_t)cur.pn * tstepB;
    PG8_STAGE(PG8_SB(0, 0), cB, voffB); PG8_STAGE(PG8_SA(0, 0), cA, voffA); PG8_STAGE(PG8_SB(0, 1), cB + hstepB, voffB); PG8_STAGE(PG8_SA(0, 1), cA + hstepA, voffA);
    if (wr == 1) PG8_BAR;
    PG8_WAIT_V(4); PG8_BAR;
    PG8_STAGE(PG8_SB(1, 0), cB + kstep, voffB); PG8_STAGE(PG8_SA(1, 0), cA + kstepA, voffA); PG8_STAGE(PG8_SB(1, 1), cB + hstepB + kstep, voffB);
    PG8_WAIT_V(6); PG8_BAR;
    for (;;) {
        const bool has_next = S.next(ui + 1, nxt);
        const char* nA = has_next ? (const char*)(g.A + (size_t)nxt.grp * g.a_gs) + (size_t)nxt.pm * tstepA : cA;
        const char* nB = has_next ? (const char*)(g.Bt + (size_t)nxt.grp * g.b_gs) + (size_t)nxt.pn * tstepB : cB;
        for (int t = 0; t < nt; t += 2) {
            const bool last = (t == nt - 2);
            const char* a1 = cA + (size_t)(t + 1) * kstepA;
            const char* a2 = last ? nA : cA + (size_t)(t + 2) * kstepA; const char* b2 = last ? nB : cB + (size_t)(t + 2) * kstep;
            const char* sA11 = a1 + hstepA; const char* sB00 = b2; const char* sA00 = a2; const char* sB01 = b2 + hstepB; const char* sA01 = a2 + hstepA;
            const char* sB10 = b2 + kstep; const char* sA10 = a2 + kstepA; const char* sB11 = b2 + kstep + hstepB;
            asm volatile("" : "+s"(sA11), "+s"(sB00), "+s"(sA00), "+s"(sB01)); asm volatile("" : "+s"(sA01), "+s"(sB10), "+s"(sA10), "+s"(sB11));
            PG8_LDB(B0, 0, 0); PG8_SCHED; PG8_LDA(At, 0, 0); PG8_STAGE(PG8_SA(1, 1), sA11, voffA);
            PG8_WAIT_L(8); PG8_BAR; PG8_WAIT_L(0); PG8_MMA(0, 0, At, B0); PG8_BAR; PG8_SCHED;
            PG8_LDB(B1, 0, 1); PG8_STAGE(PG8_SB(0, 0), sB00, voffB);
            PG8_BAR; PG8_WAIT_L(0); PG8_MMA(0, 1, At, B1); PG8_BAR;
            PG8_LDA(At, 0, 1); PG8_STAGE(PG8_SA(0, 0), sA00, voffA);
            PG8_BAR; PG8_WAIT_L(0); PG8_MMA(1, 0, At, B0); PG8_BAR; PG8_SCHED;
            PG8_STAGE(PG8_SB(0, 1), sB01, voffB);
            PG8_WAIT_V(6); PG8_BAR; PG8_MMA(1, 1, At, B1); PG8_BAR;
            PG8_LDB(B0, 1, 0); PG8_SCHED; PG8_LDA(At, 1, 0); PG8_STAGE(PG8_SA(0, 1), sA01, voffA);
            PG8_WAIT_L(8); PG8_BAR; PG8_WAIT_L(0); PG8_MMA(0, 0, At, B0); PG8_BAR; PG8_SCHED;
            PG8_LDB(B1, 1, 1); PG8_STAGE(PG8_SB(1, 0), sB10, voffB);
            PG8_BAR; PG8_WAIT_L(0); PG8_MMA(0, 1, At, B1); PG8_BAR;
            PG8_LDA(At, 1, 1); PG8_STAGE(PG8_SA(1, 0), sA10, voffA);
            PG8_BAR; PG8_WAIT_L(0); PG8_MMA(1, 0, At, B0); PG8_BAR; PG8_SCHED;
            PG8_STAGE(PG8_SB(1, 1), sB11, voffB);
            PG8_WAIT_V(6); PG8_BAR; PG8_MMA(1, 1, At, B1); PG8_BAR;
        }
        E(acc, cur, wr, wc, fr, fq);
        if (!has_next) break;
#pragma unroll
        for (int a = 0; a < 2; ++a)
#pragma unroll
            for (int b = 0; b < 2; ++b)
#pragma unroll
                for (int m = 0; m < 4; ++m)
#pragma unroll
                    for (int n = 0; n < 2; ++n) zero4(acc[a][b][m][n]);
        cur = nxt; cA = nA; cB = nB; ++ui;
    }
    PG8_WAIT_V(0);
    if (wr == 0) PG8_BAR;
    PG8_BAR;
#undef PG8_SA
#undef PG8_SB
#undef PG8_STAGE
#undef PG8_LDA
#undef PG8_LDB
#undef PG8_MMA
#undef PG8_WAIT_V
#undef PG8_WAIT_L
#undef PG8_BAR
#undef PG8_SCHED
}
}
using pg8::Unit;

struct XPtr { float* out; float* xc;
    __device__ __forceinline__ float* tile(int pm) const { return pm < 128 ? out + (size_t)pm * 256 * D : xc + (size_t)(pm - 128) * 256 * D; } };


#define RMW_ROWOFF(g) ((size_t)((((g) >> 2) * 128) + (((g) & 3) * 16)))
template <bool ZAUX, int CH, class F>
__device__ __forceinline__ void rmw_pipeline(float* xb, const float* xs, const bf16_t* zb, F&& f) {
    constexpr int SPG = 4 / CH, NST = 8 * SPG;
    f32x4 xv[2][CH]; u32x2 zz[2][CH];
#define RMW_ISSUE(st, s_) do { const int g_ = (st) / SPG, c0_ = ((st) % SPG) * CH; const float* rp = xs + RMW_ROWOFF(g_) * D; \
        _Pragma("unroll") for (int c = 0; c < CH; ++c) { const int cc = c0_ + c; xv[s_][c] = *(const f32x4*)(rp + (cc >> 1) * 128 + (cc & 1) * 16); \
            if (ZAUX) zz[s_][c] = *(const u32x2*)(zb + RMW_ROWOFF(g_) * 16 + (size_t)((cc >> 1) * 8 + (cc & 1)) * NROW * 16); } } while (0)
    RMW_ISSUE(0, 0); RMW_ISSUE(1, 1);
    __builtin_amdgcn_sched_barrier(0);
#pragma unroll
    for (int st = 0; st < NST; ++st) { const int s_ = st % 2, g = st / SPG, c0 = (st % SPG) * CH; float* wp = xb + RMW_ROWOFF(g) * D;
#pragma unroll
        for (int c = 0; c < CH; ++c) { const int cc = c0 + c; *(f32x4*)(wp + (cc >> 1) * 128 + (cc & 1) * 16) = f(g, cc, xv[s_][c], zz[s_][c]); }
        if (st + 2 < NST) RMW_ISSUE(st + 2, s_);
        __builtin_amdgcn_sched_barrier(0); }
#undef RMW_ISSUE
}

struct EpiM1 {
    static constexpr bool PERM = true;
    bf16_t* O; const float* bias;
    __device__ __forceinline__ void operator()(const f32x4 (&acc)[2][2][4][2], const Unit& u, int wr, int wc, int fr, int fq) const {
        const int row0 = u.pm * 256 + wr * 64 + fr, col0 = u.pn * 256 + wc * 32 + 8 * fq;
        f32x4 bv[2][2];
#pragma unroll
        for (int bj = 0; bj < 2; ++bj)
#pragma unroll
            for (int n = 0; n < 2; ++n) bv[bj][n] = *(const f32x4*)(bias + col0 + bj * 128 + 4 * n);
#pragma unroll
        for (int ai = 0; ai < 2; ++ai)
#pragma unroll
            for (int m = 0; m < 4; ++m) { bf16_t* rowp = O + (size_t)(row0 + ai * 128 + m * 16) * DFF + col0;
#pragma unroll
                for (int bj = 0; bj < 2; ++bj) { f32x4 v0 = acc[ai][bj][m][0] + bv[bj][0], v1 = acc[ai][bj][m][1] + bv[bj][1];
#pragma unroll
                    for (int j = 0; j < 4; ++j) { const float a0 = fmaxf(v0[j], 0.f), a1 = fmaxf(v1[j], 0.f); v0[j] = a0 * a0; v1[j] = a1 * a1; }
                    u32x4 w; w.x = pk2(v0[0], v0[1]); w.y = pk2(v0[2], v0[3]); w.z = pk2(v1[0], v1[1]); w.w = pk2(v1[2], v1[3]);
                    *(u32x4*)(rowp + bj * 128) = w; } }
    }
};
struct EpiM2 {
    static constexpr bool PERM = false;
    XPtr X; const float* bias; const float* modl; float gsc;
    __device__ __forceinline__ void operator()(const f32x4 (&acc)[2][2][4][2], const Unit& u, int wr, int wc, int fr, int fq) const {
        const int col0 = u.pn * 256 + wc * 32 + 4 * fq; const int bi = u.pm < 128 ? (u.pm >> 5) : 4;
        const float* gate = modl + bi * 6144 + 5120;
        float* xb = X.tile(u.pm) + (size_t)(wr * 64 + fr) * D + col0;
        f32x4 bv[2][2], gv[2][2];
#pragma unroll
        for (int bj = 0; bj < 2; ++bj)
#pragma unroll
            for (int n = 0; n < 2; ++n) { bv[bj][n] = *(const f32x4*)(bias + col0 + bj * 128 + n * 16); gv[bj][n] = *(const f32x4*)(gate + col0 + bj * 128 + n * 16) * gsc; }
        rmw_pipeline<false, 4>(xb, xb, nullptr, [&](int g, int c, f32x4 xv, u32x2) { return xv + gv[c >> 1][c & 1] * (acc[g >> 2][c >> 1][g & 3][c & 1] + bv[c >> 1][c & 1]); });
    }
};
struct EpiGLU {
    static constexpr bool PERM = false;
    XPtr X; const bf16_t* Z; const float* bias; const float* modl; float gsc; const float* xsrc;
    __device__ __forceinline__ void operator()(const f32x4 (&acc)[2][2][4][2], const Unit& u, int wr, int wc, int fr, int fq) const {
        const int col0 = u.pn * 256 + wc * 32 + 4 * fq; const int bi = u.pm < 128 ? (u.pm >> 5) : 4;
        const float* gate = modl + bi * 6144 + 2048;
        float* xb = X.tile(u.pm) + (size_t)(wr * 64 + fr) * D + col0;
        const float* xs = xsrc + ((size_t)u.pm * 256 + wr * 64 + fr) * D + col0;
        const bf16_t* zb = Z + ((size_t)(col0 >> 4) * NROW + u.pm * 256 + wr * 64 + fr) * 16 + (col0 & 15);
        f32x4 bv[2][2], gv[2][2];
#pragma unroll
        for (int bj = 0; bj < 2; ++bj)
#pragma unroll
            for (int n = 0; n < 2; ++n) { bv[bj][n] = *(const f32x4*)(bias + col0 + bj * 128 + n * 16); gv[bj][n] = *(const f32x4*)(gate + col0 + bj * 128 + n * 16) * gsc; }
        rmw_pipeline<true, 2>(xb, xs, zb, [&](int g, int c, f32x4 xv, u32x2 zz) { const f32x4 a = acc[g >> 2][c >> 1][g & 3][c & 1] + bv[c >> 1][c & 1]; f32x4 y;
            y[0] = bflo(zz.x) * fast_sigmoid(a[0]); y[1] = bfhi(zz.x) * fast_sigmoid(a[1]); y[2] = bflo(zz.y) * fast_sigmoid(a[2]); y[3] = bfhi(zz.y) * fast_sigmoid(a[3]);
            return xv + gv[c >> 1][c & 1] * y; });
    }
};
struct EpiPool {
    static constexpr bool PERM = false;
    XPtr X; const float* pscale; const float* modl; float gsc;
    __device__ __forceinline__ void operator()(const f32x4 (&acc)[2][2][4][2], const Unit& u, int wr, int wc, int fr, int fq) const {
        const int col0 = u.grp * 256 + wc * 32 + 4 * fq; const int bi = u.pm < 128 ? (u.pm >> 5) : 4;
        const float* gate = modl + bi * 6144 + 2048;
        float* xb = X.tile(u.pm) + (size_t)(wr * 64 + fr) * D + col0;
        f32x4 gv[2][2];
#pragma unroll
        for (int bj = 0; bj < 2; ++bj)
#pragma unroll
            for (int n = 0; n < 2; ++n) gv[bj][n] = *(const f32x4*)(gate + col0 + bj * 128 + n * 16) * *(const f32x4*)(pscale + col0 + bj * 128 + n * 16) * gsc;
        rmw_pipeline<false, 4>(xb, xb, nullptr, [&](int g, int c, f32x4 xv, u32x2) { return xv + gv[c >> 1][c & 1] * acc[g >> 2][c >> 1][g & 3][c & 1]; });
    }
};
struct EpiG1 {
    static constexpr bool PERM = false;
    float* SL;
    __device__ __forceinline__ void operator()(const f32x4 (&acc)[2][2][4][2], const Unit& u, int wr, int wc, int fr, int fq) const {
        float* b = SL + ((size_t)u.grp * CR_PAD + u.pm * 256 + wr * 64 + fr) * 256 + wc * 32 + 4 * fq;
#pragma unroll
        for (int ai = 0; ai < 2; ++ai)
#pragma unroll
            for (int m = 0; m < 4; ++m) { float* rowp = b + (size_t)(ai * 128 + m * 16) * 256;
#pragma unroll
                for (int bj = 0; bj < 2; ++bj)
#pragma unroll
                    for (int n = 0; n < 2; ++n) *(f32x4*)(rowp + bj * 128 + n * 16) = acc[ai][bj][m][n]; }
    }
};
struct EpiG2 {
    static constexpr bool PERM = true;
    bf16_t* Z; const bf16_t* XS; const float* dsk;
    __device__ __forceinline__ void operator()(const f32x4 (&acc)[2][2][4][2], const Unit& u, int wr, int wc, int fr, int fq) const {
        const int g = u.grp, ho0 = 8 * (fq & 1), ch = 16 * g + ho0;
#pragma unroll
        for (int ai = 0; ai < 2; ++ai)
#pragma unroll
            for (int m = 0; m < 4; ++m) { const int cr = u.pm * 256 + ai * 128 + wr * 64 + m * 16 + fr;
                if (cr < CRR) {
                    const int trow0 = cr < 1024 ? (cr >> 8) * 8192 + (cr & 255) * 32 : NLAT + (cr - 1024) * 32;
#pragma unroll
                    for (int bj = 0; bj < 2; ++bj) { const int t = 16 * u.pn + 8 * bj + 2 * wc + (fq >> 1);
                        f32x4 v0 = acc[ai][bj][m][0], v1 = acc[ai][bj][m][1];
#pragma unroll
                        for (int j = 0; j < 4; ++j) { v0[j] = gelu_tanh(v0[j]); v1[j] = gelu_tanh(v1[j]); }
                        u32x4 w; w.x = pk2(v0[0], v0[1]); w.y = pk2(v0[2], v0[3]); w.z = pk2(v1[0], v1[1]); w.w = pk2(v1[2], v1[3]);
                        *(u32x4*)(Z + ((size_t)g * NROW + trow0 + t) * 16 + ho0) = w; } } }
    }
};

__device__ __forceinline__ void transpose_item(const float* W, int K, int N, bf16_t* WT, LAS float* scr, int item, int lane) {
    const int nblk = N / 32, kb = item / nblk, nbk = item % nblk, k0 = 64 * kb, n0 = 32 * nbk;
#pragma unroll
    for (int i = 0; i < 32; ++i) { const int kk = 2 * i + (lane >> 5); scr[kk * 33 + (lane & 31)] = W[(size_t)(k0 + kk) * N + n0 + (lane & 31)]; }
    asm volatile("s_waitcnt lgkmcnt(0)" ::: "memory");
    const int c = lane & 7;
#pragma unroll
    for (int j = 0; j < 4; ++j) { const int n = (lane >> 3) + 8 * j; const LAS float* s = scr + (8 * c) * 33 + n;
        u32x4 o; o.x = pk2(s[0 * 33], s[1 * 33]); o.y = pk2(s[2 * 33], s[3 * 33]); o.z = pk2(s[4 * 33], s[5 * 33]); o.w = pk2(s[6 * 33], s[7 * 33]);
        *(u32x4*)(WT + (size_t)(n0 + n) * K + k0 + 8 * c) = o; }
    asm volatile("s_waitcnt lgkmcnt(0)" ::: "memory");
}

__device__ __forceinline__ void s5_disc(const Params& P, int j, int dir, int g, int p, float& dar, float& dai, float& kr, float& ki) {
    const int gi = (j * 2 + dir) * 64 + g, idx = gi * 64 + p;
    const float are = P.a_re[idx], aim = P.a_im[idx], dt = expf(P.log_dt[gi]);
    dar = are * dt; dai = aim * dt;
    float lr, li; cpowk(dar, dai, 1, lr, li);
    const float den = are * are + aim * aim, nr = lr - 1.0f, ni = li;
    kr = (nr * are + ni * aim) / den; ki = (ni * are - nr * aim) / den;
}

__device__ __forceinline__ void norm_row_tm(const float* xr, const float* gam, const float* sh, const float* sc, bf16_t* orow, int lane) {
    f32x4 v[4]; float ss = 0.f;
#pragma unroll
    for (int j = 0; j < 4; ++j) { v[j] = ((const f32x4*)xr)[lane + 64 * j]; ss += (v[j][0] * v[j][0] + v[j][1] * v[j][1]) + (v[j][2] * v[j][2] + v[j][3] * v[j][3]); }
    const float rstd = rsqrtf(wave_sum(ss) * (1.0f / D) + 1e-6f);
#pragma unroll
    for (int j = 0; j < 4; ++j) { const int cidx = lane + 64 * j;
        const f32x4 gg = ((const f32x4*)gam)[cidx], s1 = ((const f32x4*)sc)[cidx], s0 = ((const f32x4*)sh)[cidx];
        const f32x4 o = v[j] * rstd * gg * (s1 + 1.0f) + s0;
        u32x2 w; w.x = pk2(o[0], o[1]); w.y = pk2(o[2], o[3]);
        ((u32x2*)orow)[cidx] = w; }
}


__device__ __forceinline__ void norm_rows2_tm(const float* x0, const float* x1, const float* gam, const float* md0, const float* md1, bf16_t* o0, bf16_t* o1, int lane) {
    f32x4 v0[4], v1[4], gg[4], c0[4], h0[4], c1[4], h1[4];
#pragma unroll
    for (int j = 0; j < 4; ++j) { const int cidx = lane + 64 * j; v0[j] = ((const f32x4*)x0)[cidx]; v1[j] = ((const f32x4*)x1)[cidx]; }
#pragma unroll
    for (int j = 0; j < 4; ++j) { const int cidx = lane + 64 * j; gg[j] = ((const f32x4*)gam)[cidx];
        c0[j] = ((const f32x4*)(md0 + 1024))[cidx]; h0[j] = ((const f32x4*)md0)[cidx]; c1[j] = ((const f32x4*)(md1 + 1024))[cidx]; h1[j] = ((const f32x4*)md1)[cidx]; }
    __builtin_amdgcn_sched_barrier(0);
    float s0 = 0.f, s1 = 0.f;
#pragma unroll
    for (int j = 0; j < 4; ++j) { s0 += (v0[j][0] * v0[j][0] + v0[j][1] * v0[j][1]) + (v0[j][2] * v0[j][2] + v0[j][3] * v0[j][3]);
        s1 += (v1[j][0] * v1[j][0] + v1[j][1] * v1[j][1]) + (v1[j][2] * v1[j][2] + v1[j][3] * v1[j][3]); }
    const float r0 = rsqrtf(wave_sum(s0) * (1.0f / D) + 1e-6f), r1 = rsqrtf(wave_sum(s1) * (1.0f / D) + 1e-6f);
#pragma unroll
    for (int j = 0; j < 4; ++j) { const int cidx = lane + 64 * j;
        const f32x4 a0 = v0[j] * r0 * gg[j] * (c0[j] + 1.0f) + h0[j];
        const f32x4 a1 = v1[j] * r1 * gg[j] * (c1[j] + 1.0f) + h1[j];
        u32x2 w; w.x = pk2(a0[0], a0[1]); w.y = pk2(a0[2], a0[3]); ((u32x2*)o0)[cidx] = w;
        w.x = pk2(a1[0], a1[1]); w.y = pk2(a1[2], a1[3]); ((u32x2*)o1)[cidx] = w; }
}


template <int MT, int K>
__device__ __forceinline__ void ctx_tile(LAS float* part, const bf16_t* A, int lda, const bf16_t* Bt, int ldb, int tid, int a_gm = 0) {
    const int wave = tid >> 6, lane = tid & 63, fr = lane & 15, fq = lane >> 4;
    constexpr int MI = MT / 16;
    f32x4 acc[MI][4];
#pragma unroll
    for (int mi = 0; mi < MI; ++mi)
#pragma unroll
        for (int ni = 0; ni < 4; ++ni) acc[mi][ni] = (f32x4){0.f, 0.f, 0.f, 0.f};
    constexpr int kw = K >> 3;
    const bf16_t* a0 = A + (size_t)fr * lda + wave * kw + fq * 8;
    const bf16_t* b0 = Bt + (size_t)fr * ldb + wave * kw + fq * 8;
    bf16x8 af[2][MI], bfr[2][4];
#define CT_LOAD(buf, k) do { _Pragma("unroll") for (int mi = 0; mi < MI; ++mi) { const int kk = wave * kw + (k) + fq * 8; \
            af[buf][mi] = a_gm ? *(const bf16x8*)(A + ((size_t)(kk >> 4) * a_gm + mi * 16 + fr) * 16 + (kk & 15)) : *(const bf16x8*)(a0 + (size_t)mi * 16 * lda + (k)); } \
        _Pragma("unroll") for (int ni = 0; ni < 4; ++ni) bfr[buf][ni] = *(const bf16x8*)(b0 + (size_t)ni * 16 * ldb + (k)); } while (0)
#define CT_MMA(buf) do { _Pragma("unroll") for (int mi = 0; mi < MI; ++mi) _Pragma("unroll") for (int ni = 0; ni < 4; ++ni) \
            acc[mi][ni] = __builtin_amdgcn_mfma_f32_16x16x32_bf16(bfr[buf][ni], af[buf][mi], acc[mi][ni], 0, 0, 0); } while (0)
    CT_LOAD(0, 0);
#pragma unroll
    for (int k = 0; k < kw; k += 64) {
        if (k + 32 < kw) CT_LOAD(1, k + 32);
        __builtin_amdgcn_sched_barrier(0);
        CT_MMA(0);
        __builtin_amdgcn_sched_barrier(0);
        if (k + 64 < kw) CT_LOAD(0, k + 64);
        __builtin_amdgcn_sched_barrier(0);
        if (k + 32 < kw) CT_MMA(1);
        __builtin_amdgcn_sched_barrier(0);
    }
#undef CT_LOAD
#undef CT_MMA
    LAS float* pw = part + wave * (MT * 68);
#pragma unroll
    for (int mi = 0; mi < MI; ++mi)
#pragma unroll
        for (int ni = 0; ni < 4; ++ni) *(LAS f32x4*)(pw + (mi * 16 + fr) * 68 + ni * 16 + 4 * fq) = acc[mi][ni];
}
template <int MT>
__device__ __forceinline__ f32x4 ctx_reduce(const LAS float* part, int row, int c4) {
    f32x4 s = *(const LAS f32x4*)(part + row * 68 + c4);
#pragma unroll
    for (int w = 1; w < 8; ++w) s += *(const LAS f32x4*)(part + w * (MT * 68) + row * 68 + c4);
    return s;
}


template <int W>
__device__ __forceinline__ void pool_lat_item(const bf16_t* XN, bf16_t* Zb, LAS float* ldsf, int b, int r, int gi, int tid) {
    const int rlo = max(r - W / 2, 0), rhi = min(r + W - W / 2, 128);
#pragma unroll 1
    for (int i = 0; i < 4; ++i) { const int e = tid + 512 * i, c = e >> 5, cv = e & 31;
        const bf16_t* src = XN + ((size_t)b * 8192 + c) * D + 256 * gi + 8 * cv;
        u32x4 uu[W];
#pragma unroll
        for (int k = 0; k < W; ++k) { int rr = r - W / 2 + k; rr = rr < 0 ? 0 : (rr > 127 ? 127 : rr); uu[k] = *(const u32x4*)(src + (size_t)rr * 64 * D); }
        float a[8];
#pragma unroll
        for (int q = 0; q < 8; ++q) a[q] = 0.f;
#pragma unroll
        for (int k = 0; k < W; ++k) { const int rr = r - W / 2 + k; const float m = (rr >= 0 && rr < 128) ? 1.0f : 0.0f;
            a[0] += m * bflo(uu[k].x); a[1] += m * bfhi(uu[k].x); a[2] += m * bflo(uu[k].y); a[3] += m * bfhi(uu[k].y);
            a[4] += m * bflo(uu[k].z); a[5] += m * bfhi(uu[k].z); a[6] += m * bflo(uu[k].w); a[7] += m * bfhi(uu[k].w); }
        LAS f32x4* d4 = (LAS f32x4*)(ldsf + c * 256 + 8 * cv);
        d4[0] = (f32x4){a[0], a[1], a[2], a[3]}; d4[1] = (f32x4){a[4], a[5], a[6], a[7]}; }
    __syncthreads();
#pragma unroll 1
    for (int i = 0; i < 4; ++i) { const int e = tid + 512 * i, c = e >> 5, cv = e & 31;
        const u32x4 uc = *(const u32x4*)(XN + ((size_t)b * 8192 + r * 64 + c) * D + 256 * gi + 8 * cv);
        const int clo = max(c - W / 2, 0), chi = min(c + W - W / 2, 64);
        f32x4 t0 = (f32x4){0.f, 0.f, 0.f, 0.f}, t1 = t0;
#pragma unroll
        for (int k = 0; k < W; ++k) { const int cc = c - W / 2 + k; const int ccc = cc < 0 ? 0 : (cc > 63 ? 63 : cc); const float m = (cc >= 0 && cc < 64) ? 1.0f : 0.0f;
            const LAS f32x4* s4 = (const LAS f32x4*)(ldsf + ccc * 256 + 8 * cv); t0 += s4[0] * m; t1 += s4[1] * m; }
        const float inv = 1.0f / (float)((rhi - rlo) * (chi - clo));
        u32x4 wv; wv.x = pk2(t0[0] * inv - bflo(uc.x), t0[1] * inv - bfhi(uc.x)); wv.y = pk2(t0[2] * inv - bflo(uc.y), t0[3] * inv - bfhi(uc.y));
        wv.z = pk2(t1[0] * inv - bflo(uc.z), t1[1] * inv - bfhi(uc.z)); wv.w = pk2(t1[2] * inv - bflo(uc.w), t1[3] * inv - bfhi(uc.w));
        *(u32x4*)(Zb + ((size_t)b * 8192 + r * 64 + c) * D + 256 * gi + 8 * cv) = wv; }
    __syncthreads();
}


template <int W>
__device__ __forceinline__ void pool_band_item(const bf16_t* XN, bf16_t* Zb, LAS float* ldsf, int b, int r0, int gi, int cq, int tid) {
    constexpr int NL = W + 3;
    const int c = tid >> 3, cv = tid & 7, chb = 256 * gi + 64 * cq + 8 * cv;
    const bf16_t* src = XN + ((size_t)b * 8192 + c) * D + chb;
    u32x4 uu[NL];
#pragma unroll
    for (int k = 0; k < NL; ++k) { int rr = r0 - W / 2 + k; rr = rr < 0 ? 0 : (rr > 127 ? 127 : rr); uu[k] = *(const u32x4*)(src + (size_t)rr * 64 * D); }
#pragma unroll
    for (int k = 0; k < NL; ++k) { const int rr = r0 - W / 2 + k; if (rr < 0 || rr > 127) uu[k] = (u32x4){0u, 0u, 0u, 0u}; }
    float vs[8];
#pragma unroll
    for (int q = 0; q < 8; ++q) vs[q] = 0.f;
#pragma unroll
    for (int k = 0; k < W; ++k) { vs[0] += bflo(uu[k].x); vs[1] += bfhi(uu[k].x); vs[2] += bflo(uu[k].y); vs[3] += bfhi(uu[k].y); vs[4] += bflo(uu[k].z); vs[5] += bfhi(uu[k].z); vs[6] += bflo(uu[k].w); vs[7] += bfhi(uu[k].w); }
    const int clo = max(c - W / 2, 0), chi = min(c + W - W / 2, 64);
#pragma unroll
    for (int dr = 0; dr < 4; ++dr) {
        if (dr > 0) { const u32x4 a = uu[W - 1 + dr], o = uu[dr - 1];
            vs[0] += bflo(a.x) - bflo(o.x); vs[1] += bfhi(a.x) - bfhi(o.x); vs[2] += bflo(a.y) - bflo(o.y); vs[3] += bfhi(a.y) - bfhi(o.y);
            vs[4] += bflo(a.z) - bflo(o.z); vs[5] += bfhi(a.z) - bfhi(o.z); vs[6] += bflo(a.w) - bflo(o.w); vs[7] += bfhi(a.w) - bfhi(o.w); }
        LAS float* lbuf = ldsf + (dr & 1) * 4096;
        LAS f32x4* d4 = (LAS f32x4*)(lbuf + c * 64 + 8 * cv);
        d4[0] = (f32x4){vs[0], vs[1], vs[2], vs[3]}; d4[1] = (f32x4){vs[4], vs[5], vs[6], vs[7]};
        __syncthreads();
        const int r = r0 + dr, rlo = max(r - W / 2, 0), rhi = min(r + W - W / 2, 128);
        f32x4 t0 = (f32x4){0.f, 0.f, 0.f, 0.f}, t1 = t0;
#pragma unroll
        for (int k = 0; k < W; ++k) { const int cc = c - W / 2 + k; const int ccc = cc < 0 ? 0 : (cc > 63 ? 63 : cc); const float m = (cc >= 0 && cc < 64) ? 1.0f : 0.0f;
            const LAS f32x4* s4 = (const LAS f32x4*)(lbuf + ccc * 64 + 8 * cv); t0 += s4[0] * m; t1 += s4[1] * m; }
        const float inv = 1.0f / (float)((rhi - rlo) * (chi - clo));
        const u32x4 uc = uu[W / 2 + dr];
        u32x4 wv; wv.x = pk2(t0[0] * inv - bflo(uc.x), t0[1] * inv - bfhi(uc.x)); wv.y = pk2(t0[2] * inv - bflo(uc.y), t0[3] * inv - bfhi(uc.y));
        wv.z = pk2(t1[0] * inv - bflo(uc.z), t1[1] * inv - bfhi(uc.z)); wv.w = pk2(t1[2] * inv - bflo(uc.w), t1[3] * inv - bfhi(uc.w));
        *(u32x4*)(Zb + ((size_t)b * 8192 + r * 64 + c) * D + chb) = wv;
    }
}

__global__ void __launch_bounds__(512, 2) fwd_kernel(Params P) {
    extern __shared__ __attribute__((aligned(16))) unsigned char shm_raw[];
    LAS unsigned char* lds = (LAS unsigned char*)shm_raw;
    LAS float* ldsf = (LAS float*)lds;
    cg::grid_group grid = cg::this_grid();
    const int nb = gridDim.x, bid = blockIdx.x;
#define PHASE_IDS int tid = threadIdx.x; asm volatile("" : "+v"(tid)); const int lane = tid & 63, wave = __builtin_amdgcn_readfirstlane(tid >> 6); (void)lane; (void)wave;
    unsigned char* ws = P.ws;
    bf16_t* W1T = (bf16_t*)(ws + OFF_W1); bf16_t* W2T = (bf16_t*)(ws + OFF_W2); bf16_t* WGT = (bf16_t*)(ws + OFF_WG); bf16_t* WPT = (bf16_t*)(ws + OFF_WP);
    float* MOD = (float*)(ws + OFF_MOD); float* XC = (float*)(ws + OFF_XC);
    bf16_t* XN = (bf16_t*)(ws + OFF_XN); bf16_t* Zb = (bf16_t*)(ws + OFF_Z); bf16_t* ACT = (bf16_t*)(ws + OFF_ACT);
    float* MTAB = (float*)(ws + OFF_MTAB);
    bf16_t* TC = (bf16_t*)(ws + OFF_TC); bf16_t* SM = (bf16_t*)(ws + OFF_SM); float* SL = (float*)(ws + OFF_SL); bf16_t* XS = (bf16_t*)(ws + OFF_XS);
    const XPtr XP{P.out, XC};
    pg8::Sched S;
    volatile LAS unsigned* xb_st = (volatile LAS unsigned*)(lds + LDS_BYTES - 16);
    if (threadIdx.x == 0) { xb_st[0] = 0u; xb_st[1] = 0u; }
    __syncthreads();
    (void)xcd_barrier_post((unsigned*)(ws + OFF_BAR), xb_st);
#define GBAR() do { XcdBarrier xb_; xb_.bar = (unsigned*)(P.ws + OFF_BAR); xb_.x = xb_xcc_id(); xb_.st = (volatile LAS unsigned*)(lds + LDS_BYTES - 16); xcd_barrier(xb_); } while (0)

    {
        PHASE_IDS
        LAS float* scr = (LAS float*)(lds + wave * 8704);
        const int gw = bid * 8 + wave, NGW = nb * 8;
        for (int it = gw; it < 17664; it += NGW) {
            int r = it;
            if (r < 8192) { const int l = r >> 11; transpose_item(P.w1 + (size_t)l * 4194304, 1024, 4096, W1T + (size_t)l * 4194304, scr, r & 2047, lane); continue; }
            r -= 8192;
            if (r < 8192) { const int l = r >> 11; transpose_item(P.w2 + (size_t)l * 4194304, 4096, 1024, W2T + (size_t)l * 4194304, scr, r & 2047, lane); continue; }
            r -= 8192;
            if (r < 1024) { const int jj = r >> 9; transpose_item(P.glu_w + (size_t)jj * 1048576, 1024, 1024, WGT + (size_t)jj * 1048576, scr, r & 511, lane); continue; }
            r -= 1024;
            { const int mm = r >> 5; transpose_item(P.pool_w + (size_t)mm * 65536, 256, 256, WPT + (size_t)mm * 65536, scr, r & 31, lane); }
        }
        __syncthreads();
        LAS float* sv = ldsf;
        LAS float* red = ldsf + 5120;
        for (int i = tid; i < 5120; i += 512) { const int b = i >> 10, k = i & 1023; const float v = b < 4 ? P.c[b * 1024 + k] : P.c_ctx[k]; sv[i] = v * fast_sigmoid(v); }
        __syncthreads();
        for (int pass = bid; pass < 768; pass += nb) {
            const int gcol0 = pass * 32, l = gcol0 / 6144, n0 = gcol0 % 6144, cn = tid & 31, kq = tid >> 5;
            const float* wp = P.ada_w + ((size_t)l * 1024 + kq * 64) * 6144 + n0 + cn;
            float a0 = 0.f, a1 = 0.f, a2 = 0.f, a3 = 0.f, a4 = 0.f;
#pragma unroll 16
            for (int kk = 0; kk < 64; ++kk) { const float w = wp[(size_t)kk * 6144]; const int k = kq * 64 + kk;
                a0 += sv[k] * w; a1 += sv[1024 + k] * w; a2 += sv[2048 + k] * w; a3 += sv[3072 + k] * w; a4 += sv[4096 + k] * w; }
            red[(kq * 5 + 0) * 32 + cn] = a0; red[(kq * 5 + 1) * 32 + cn] = a1; red[(kq * 5 + 2) * 32 + cn] = a2; red[(kq * 5 + 3) * 32 + cn] = a3; red[(kq * 5 + 4) * 32 + cn] = a4;
            __syncthreads();
            if (tid < 160) { const int b = tid >> 5, c2 = tid & 31; float s = P.ada_b[l * 6144 + n0 + c2];
#pragma unroll
                for (int q = 0; q < 16; ++q) s += red[(q * 5 + b) * 32 + c2];
                MOD[(size_t)(l * 5 + b) * 6144 + n0 + c2] = s; }
            __syncthreads();
        }
        LAS float* Bbr = ldsf;
        LAS float* Bbi = ldsf + 1024;
        LAS float* Ctr = ldsf + 2048;
        LAS float* Cti = ldsf + 3072;
        LAS float* pwr = ldsf + 4096;
        LAS float* pwi = ldsf + 4096 + 2112;
        for (int item = bid; item < 256; item += nb) {
            const int dir = item & 1, g = (item >> 1) & 63, j = item >> 7;
            if (tid < 64) { const int p = tid; float dar, dai, kr, ki; s5_disc(P, j, dir, g, p, dar, dai, kr, ki);
                for (int k = 0; k < 32; ++k) { float re, im; cpowk(dar, dai, k, re, im); pwr[p * 33 + k] = re; pwi[p * 33 + k] = im; }
                const size_t bb = ((size_t)((j * 2 + dir) * 64 + g) * 64 + p) * 16;
#pragma unroll
                for (int h = 0; h < 16; ++h) { const float br = P.b_re[bb + h], bi2 = P.b_im[bb + h]; Bbr[p * 16 + h] = kr * br - ki * bi2; Bbi[p * 16 + h] = kr * bi2 + ki * br; } }
            for (int e = tid; e < 1024; e += 512) { const int ho = e >> 6, p = e & 63; const size_t ci = ((size_t)((j * 2 + dir) * 64 + g) * 16 + ho) * 64 + p;
                Ctr[p * 16 + ho] = P.c_re[ci]; Cti[p * 16 + ho] = P.c_im[ci]; }
            __syncthreads();
            { const int k = tid >> 4, ho = tid & 15; float a[16];
#pragma unroll
                for (int h = 0; h < 16; ++h) a[h] = 0.f;
                for (int p = 0; p < 64; ++p) { const float cr = Ctr[p * 16 + ho], ci = Cti[p * 16 + ho], pr = pwr[p * 33 + k], pi = pwi[p * 33 + k];
                    const float cpr = cr * pr - ci * pi, cpi = cr * pi + ci * pr;
                    const LAS f32x4* br4 = (const LAS f32x4*)(Bbr + p * 16); const LAS f32x4* bi4 = (const LAS f32x4*)(Bbi + p * 16);
#pragma unroll
                    for (int q = 0; q < 4; ++q) { const f32x4 br = br4[q], bi2 = bi4[q];
#pragma unroll
                        for (int e = 0; e < 4; ++e) a[q * 4 + e] += cpr * br[e] - cpi * bi2[e]; } }
                float* mo = MTAB + ((size_t)((j * 64 + g) * 2 + dir) * 32 + k) * 256 + ho * 16;
#pragma unroll
                for (int q = 0; q < 4; ++q) ((f32x4*)mo)[q] = (f32x4){a[q * 4], a[q * 4 + 1], a[q * 4 + 2], a[q * 4 + 3]}; }
            __syncthreads();
        }
    }
    if (P.ws == nullptr) grid.sync();
    GBAR();

#pragma unroll 1
    for (int l = 0; l < 4; ++l) {
        const int j = l >> 1;
        const bool ctx_out = l < 2;
        const float* modl = MOD + (size_t)l * 5 * 6144;
        if ((l & 1) == 0) {
            {
                PHASE_IDS
                LAS float* Bbr = ldsf;
                LAS float* Bbi = ldsf + 2048;
                LAS float* Cr = ldsf + 4096;
                LAS float* Ci = ldsf + 6144;
                LAS float* pwr = ldsf + 8192;
                LAS float* pwi = ldsf + 8192 + 4224;
                const int nit = (256 + CRR - bid + nb - 1) / nb;
                for (int kq = 0; kq < nit; ++kq) {
                    const int kk = (bid & 1) ? (kq + 1 == nit ? 0 : kq + 1) : kq; const int item = bid + kk * nb;
                    if (item < 256) {
                        const int g = item >> 2, q4 = item & 3;
                        if (tid < 128) { const int dir = tid >> 6, p = tid & 63; float dar, dai, kr, ki; s5_disc(P, j, dir, g, p, dar, dai, kr, ki);
                            for (int k = 0; k < 33; ++k) { float re, im; cpowk(dar, dai, k, re, im); pwr[(dir * 33 + k) * 64 + p] = re; pwi[(dir * 33 + k) * 64 + p] = im; }
                            const size_t bb = ((size_t)((j * 2 + dir) * 64 + g) * 64 + p) * 16;
#pragma unroll
                            for (int h = 0; h < 16; ++h) { const float br = P.b_re[bb + h], bi2 = P.b_im[bb + h]; Bbr[(dir * 64 + p) * 16 + h] = kr * br - ki * bi2; Bbi[(dir * 64 + p) * 16 + h] = kr * bi2 + ki * br; } }
                        for (int e = tid; e < 2048; e += 512) { const int dir = e >> 10, r2 = e & 1023; const size_t ci = (size_t)((j * 2 + dir) * 64 + g) * 1024 + r2;
                            Cr[e] = P.c_re[ci]; Ci[e] = P.c_im[ci]; }
                        LAS float* Ml = ldsf + 16640;
                        { const f32x4* msrc = (const f32x4*)(MTAB + (size_t)((j * 64 + g) * 2 + 0) * 8192);
#pragma unroll
                            for (int q = 0; q < 8; ++q) { const int e = tid + 512 * q; *(LAS f32x4*)(Ml + (e >> 6) * 260 + (e & 63) * 4) = msrc[e]; } }
                        __syncthreads();
                        const LAS float* Mf = Ml; const LAS float* Mb = Ml + 32 * 260;
                        const float dsk_ho_base = 0.f; (void)dsk_ho_base;
                        for (int e = tid; e < 12288; e += 512) { const int nl = e / 96, kv = e % 96, n = 128 * q4 + nl, t = n >> 4, ho = n & 15, k0 = kv * 8;
                            float v[8];
                            if (k0 < 512) { const int s = k0 >> 4, hi0 = k0 & 15;
#pragma unroll
                                for (int i = 0; i < 8; ++i) v[i] = 0.f;
                                if (t >= s) { const f32x4 m0 = *(const LAS f32x4*)(Mf + (t - s) * 260 + ho * 16 + hi0), m1 = *(const LAS f32x4*)(Mf + (t - s) * 260 + ho * 16 + hi0 + 4);
#pragma unroll
                                    for (int i = 0; i < 4; ++i) { v[i] += m0[i]; v[4 + i] += m1[i]; } }
                                if (s >= t) { const f32x4 m0 = *(const LAS f32x4*)(Mb + (s - t) * 260 + ho * 16 + hi0), m1 = *(const LAS f32x4*)(Mb + (s - t) * 260 + ho * 16 + hi0 + 4);
#pragma unroll
                                    for (int i = 0; i < 4; ++i) { v[i] += m0[i]; v[4 + i] += m1[i]; } }
                                if (s == t) { const float dsk = P.s5_d[j * 1024 + 16 * g + ho];
#pragma unroll
                                    for (int i = 0; i < 8; ++i) v[i] += (hi0 + i == ho) ? dsk : 0.f; }
                            } else { const int q = k0 - 512, dir = q >> 7, part = (q >> 6) & 1, p0 = q & 63, ee = dir ? 32 - t : t + 1;
#pragma unroll
                                for (int i = 0; i < 8; ++i) { const int p = p0 + i; const float cr = Cr[(dir * 16 + ho) * 64 + p], ci = Ci[(dir * 16 + ho) * 64 + p], pr = pwr[(dir * 33 + ee) * 64 + p], pi = pwi[(dir * 33 + ee) * 64 + p];
                                    v[i] = part ? -(cr * pi + ci * pr) : (cr * pr - ci * pi); } }
                            u32x4 w; w.x = pk2(v[0], v[1]); w.y = pk2(v[2], v[3]); w.z = pk2(v[4], v[5]); w.w = pk2(v[6], v[7]);
                            *(u32x4*)(TC + ((size_t)g * 512 + n) * XS_K + k0) = w; }
                        for (int e = tid; e < 4096; e += 512) { const int ql = e >> 6, kv = e & 63, q = 64 * q4 + ql, dir = q >> 7, part = (q >> 6) & 1, p = q & 63, k0 = kv * 8, s = k0 >> 4, hi0 = k0 & 15, ee = dir ? s : 31 - s;
                            const float pr = pwr[(dir * 33 + ee) * 64 + p], pi = pwi[(dir * 33 + ee) * 64 + p];
                            float v[8];
#pragma unroll
                            for (int i = 0; i < 8; ++i) { const float br = Bbr[(dir * 64 + p) * 16 + hi0 + i], bi2 = Bbi[(dir * 64 + p) * 16 + hi0 + i]; v[i] = part ? (pr * bi2 + pi * br) : (pr * br - pi * bi2); }
                            u32x4 w; w.x = pk2(v[0], v[1]); w.y = pk2(v[2], v[3]); w.z = pk2(v[4], v[5]); w.w = pk2(v[6], v[7]);
                            *(u32x4*)(SM + ((size_t)g * 256 + q) * 512 + k0) = w; }
                        __syncthreads();
                    } else {
                        const int cr = item - 256; const int bi = cr < 1024 ? (cr >> 8) : 4;
                        const int row0 = cr < 1024 ? (cr >> 8) * 8192 + (cr & 255) * 32 : NLAT + (cr - 1024) * 32;
                        const float* gam = P.norm1_g + l * 1024 + 16 * lane; const float* shp = modl + bi * 6144 + 16 * lane; const float* scp = shp + 1024;
                        f32x4 gs[4], sh[4];
#pragma unroll
                        for (int q = 0; q < 4; ++q) { gs[q] = ((const f32x4*)gam)[q] * (((const f32x4*)scp)[q] + 1.0f); sh[q] = ((const f32x4*)shp)[q]; }
                        {
                            f32x4 v[4][4]; float ss[4];
#pragma unroll
                            for (int r = 0; r < 4; ++r) { const int row = row0 + wave + 8 * r;
                                const float* src = (l == 0) ? (row < NLAT ? P.x + (size_t)row * D : P.ctx + (size_t)(row - NLAT) * D) : (row < NLAT ? P.out + (size_t)row * D : XC + (size_t)(row - NLAT) * D);
#pragma unroll
                                for (int q = 0; q < 4; ++q) v[r][q] = ((const f32x4*)(src + 16 * lane))[q]; }
                            __builtin_amdgcn_sched_barrier(0);
#pragma unroll
                            for (int r = 0; r < 4; ++r) { ss[r] = 0.f;
#pragma unroll
                                for (int q = 0; q < 4; ++q) ss[r] += (v[r][q][0] * v[r][q][0] + v[r][q][1] * v[r][q][1]) + (v[r][q][2] * v[r][q][2] + v[r][q][3] * v[r][q][3]); }
#pragma unroll
                            for (int r = 0; r < 4; ++r) { const int t = wave + 8 * r;
                                const float rstd = rsqrtf(wave_sum(ss[r]) * (1.0f / D) + 1e-6f);
                                u32x4 w0, w1; f32x4 o;
                                o = v[r][0] * rstd * gs[0] + sh[0]; w0.x = pk2(o[0], o[1]); w0.y = pk2(o[2], o[3]);
                                o = v[r][1] * rstd * gs[1] + sh[1]; w0.z = pk2(o[0], o[1]); w0.w = pk2(o[2], o[3]);
                                o = v[r][2] * rstd * gs[2] + sh[2]; w1.x = pk2(o[0], o[1]); w1.y = pk2(o[2], o[3]);
                                o = v[r][3] * rstd * gs[3] + sh[3]; w1.z = pk2(o[0], o[1]); w1.w = pk2(o[2], o[3]);
                                LAS u32x4* dq = (LAS u32x4*)(lds + lane * 1040 + t * 32);
                                dq[0] = w0; dq[1] = w1; } }
                        __syncthreads();
#pragma unroll
                        for (int gq = 0; gq < 8; ++gq) { const int g = wave * 8 + gq;
                            const u32x4 w = *(const LAS u32x4*)(lds + g * 1040 + lane * 16);
                            *(u32x4*)(XS + ((size_t)g * CRR + cr) * XS_K + lane * 8) = w; }
                        __syncthreads();
                    }
                }
            }
            GBAR();
            { pg8::Gemm gm{XS, SM, XS_K, 512, (long)CRR * XS_K, 256L * 512, 0}; S.init(4, 1, 64, nb, bid); EpiG1 E{SL}; pg8::gemm_phase(lds, gm, S, E); }
            { PHASE_IDS
                for (int item = bid; item < 256; item += nb) { const int g = item >> 2, q = item & 3;
                    ctx_tile<32, 512>(ldsf, XS + ((size_t)g * CRR + 1024) * XS_K, XS_K, SM + ((size_t)g * 256 + q * 64) * 512, 512, tid);
                    __syncthreads();
                    { const int row = tid >> 4, c4 = (tid & 15) * 4; const f32x4 v = ctx_reduce<32>(ldsf, row, c4);
                        *(f32x4*)(SL + ((size_t)g * CR_PAD + 1024 + row) * 256 + q * 64 + c4) = v; }
                    __syncthreads(); } }
            GBAR();
            {
                PHASE_IDS
                LAS float* er = ldsf; LAS float* ei = ldsf + 512;
                for (int item = bid; item < 512; item += nb) {
                    const int dir = item & 1, g = (item >> 1) & 63, b = item >> 7, p = lane, seg = wave;
                    float dar, dai, kr, ki; s5_disc(P, j, dir, g, p, dar, dai, kr, ki);
                    float Ar, Ai, A33r, A33i; cpowk(dar, dai, 32, Ar, Ai); cpowk(dar, dai, 32 * 33, A33r, A33i);
                    const float* sl = SL + (size_t)g * CR_PAD * 256 + dir * 128 + p;
                    float vr[33], vi[33];
#pragma unroll
                    for (int jj = 0; jj < 33; ++jj) { const int i = seg * 33 + jj; const int cr = i < 8 ? 1024 + b * 8 + (dir ? 7 - i : i) : b * 256 + (dir ? 263 - i : i - 8);
                        vr[jj] = sl[(size_t)cr * 256]; vi[jj] = sl[(size_t)cr * 256 + 64]; }
#pragma unroll
                    for (int jj = 1; jj < 33; ++jj) { const float nr = Ar * vr[jj - 1] - Ai * vi[jj - 1] + vr[jj], ni = Ar * vi[jj - 1] + Ai * vr[jj - 1] + vi[jj]; vr[jj] = nr; vi[jj] = ni; }
                    er[seg * 64 + p] = vr[32]; ei[seg * 64 + p] = vi[32];
                    __syncthreads();
                    float cr_ = 0.f, ci_ = 0.f;
                    for (int s2 = 0; s2 < seg; ++s2) { const float nr = A33r * cr_ - A33i * ci_ + er[s2 * 64 + p], ni = A33r * ci_ + A33i * cr_ + ei[s2 * 64 + p]; cr_ = nr; ci_ = ni; }
                    __syncthreads();
                    bf16_t* xo = XS + (size_t)g * CRR * XS_K + 512 + dir * 128 + p;
#pragma unroll
                    for (int jj = 0; jj < 33; ++jj) { const int i = seg * 33 + jj; const int cr = i < 8 ? 1024 + b * 8 + (dir ? 7 - i : i) : b * 256 + (dir ? 263 - i : i - 8);
                        const float orr = jj == 0 ? cr_ : vr[jj - 1] + cr_, oi = jj == 0 ? ci_ : vi[jj - 1] + ci_;
                        const unsigned w = pk2(orr, oi);
                        xo[(size_t)cr * XS_K] = (bf16_t)(w & 0xffffu); xo[(size_t)cr * XS_K + 64] = (bf16_t)(w >> 16);
                        const float nr = Ar * cr_ - Ai * ci_, ni = Ar * ci_ + Ai * cr_; cr_ = nr; ci_ = ni; }
                }
            }
            GBAR();
            { pg8::Gemm gm{XS, TC, XS_K, XS_K, (long)CRR * XS_K, 512L * XS_K, 0}; S.init(4, 2, 64, nb, bid); EpiG2 E{Zb, XS, P.s5_d + j * 1024}; pg8::gemm_phase(lds, gm, S, E); }
            if (ctx_out) { PHASE_IDS
                for (int item = bid; item < 512; item += nb) { const int g = item >> 3, q = item & 7;
                    ctx_tile<32, 768>(ldsf, XS + ((size_t)g * CRR + 1024) * XS_K, XS_K, TC + ((size_t)g * 512 + q * 64) * XS_K, XS_K, tid);
                    __syncthreads();
                    { const int row = tid >> 4, c4 = (tid & 15) * 4; f32x4 v = ctx_reduce<32>(ldsf, row, c4);
                        const int n = q * 64 + c4, t = n >> 4, ho = n & 15, ch = 16 * g + ho;
                        v[0] = gelu_tanh(v[0]); v[1] = gelu_tanh(v[1]); v[2] = gelu_tanh(v[2]); v[3] = gelu_tanh(v[3]);
                        u32x2 w; w.x = pk2(v[0], v[1]); w.y = pk2(v[2], v[3]);
                        *(u32x2*)(Zb + ((size_t)g * NROW + NLAT + row * 32 + t) * 16 + ho) = w; }
                    __syncthreads(); } }
            GBAR();
            { pg8::Gemm gm{Zb, WGT + (size_t)j * 1048576, 1024, 1024, 0, 0, NROW}; S.init(128, 4, 1, nb, bid); EpiGLU E{XP, Zb, P.glu_b + j * 1024, modl,  1.0f, l == 0 ? P.x : P.out}; pg8::gemm_phase(lds, gm, S, E); }
            if (ctx_out) { PHASE_IDS
                const float gsc =  1.0f;
                for (int item = bid; item < 256; item += nb) { const int rb = item >> 4, cb = item & 15;
                    ctx_tile<64, 1024>(ldsf, Zb + ((size_t)NLAT + rb * 64) * 16, D, WGT + (size_t)j * 1048576 + (size_t)cb * 64 * 1024, 1024, tid, NROW);
                    __syncthreads();
#pragma unroll
                    for (int h = 0; h < 2; ++h) { const int e = tid + 512 * h, row = e >> 4, c4 = (e & 15) * 4, col = cb * 64 + c4; const f32x4 a = ctx_reduce<64>(ldsf, row, c4) + *(const f32x4*)(P.glu_b + j * 1024 + col);
                        const u32x2 zz = *(const u32x2*)(Zb + ((size_t)(col >> 4) * NROW + NLAT + rb * 64 + row) * 16 + (col & 15));
                        f32x4 y; y[0] = bflo(zz.x) * fast_sigmoid(a[0]); y[1] = bfhi(zz.x) * fast_sigmoid(a[1]); y[2] = bflo(zz.y) * fast_sigmoid(a[2]); y[3] = bfhi(zz.y) * fast_sigmoid(a[3]);
                        f32x4* xq = (f32x4*)(XC + (size_t)(rb * 64 + row) * D + col);
                        const f32x4 xv = *(const f32x4*)((l == 0 ? P.ctx : XC) + (size_t)(rb * 64 + row) * D + col);
                        *xq = xv + *(const f32x4*)(modl + 4 * 6144 + 2048 + col) * gsc * y; }
                    __syncthreads(); } }
            GBAR();
        } else {
            { PHASE_IDS
                const int nrows = ctx_out ? NROW : NLAT;
                for (int row = bid * 8 + wave; row < nrows; row += nb * 16) { const int rw1 = (row + nb * 8 < nrows) ? row + nb * 8 : row;
                    const int bi0 = row < NLAT ? (row >> 13) : 4, bi1 = rw1 < NLAT ? (rw1 >> 13) : 4;
                    const float* xr0 = row < NLAT ? P.out + (size_t)row * D : XC + (size_t)(row - NLAT) * D;
                    const float* xr1 = rw1 < NLAT ? P.out + (size_t)rw1 * D : XC + (size_t)(rw1 - NLAT) * D;
                    norm_rows2_tm(xr0, xr1, P.norm1_g + l * 1024, modl + bi0 * 6144, modl + bi1 * 6144, XN + (size_t)row * D, XN + (size_t)rw1 * D, lane); } }
            GBAR();
            {
                PHASE_IDS
                const int nitems = 2048 + (ctx_out ? 256 : 0);
                for (int item = bid; item < nitems; item += nb) {
                    if (item < 2048) {
                        const int rest = item >> 2, gi = ((item & 3) + (item >> 8)) & 3, cq = rest & 3, r0 = ((rest >> 2) & 31) * 4, b = rest >> 7;
                        if (gi == 0) pool_band_item<2>(XN, Zb, ldsf, b, r0, gi, cq, tid);
                        else if (gi == 1) pool_band_item<4>(XN, Zb, ldsf, b, r0, gi, cq, tid);
                        else if (gi == 2) pool_band_item<8>(XN, Zb, ldsf, b, r0, gi, cq, tid);
                        else pool_band_item<16>(XN, Zb, ldsf, b, r0, gi, cq, tid);
                    } else {
                        const int ci = item - 2048, gi = ci & 3, tb = (ci >> 2) & 15, b = ci >> 6, w = 2 << gi;
                        const int t = tb * 16 + (tid >> 5), cv = tid & 31;
                        const int lo = max(t - (w >> 1), 0), hi = min(t + w - (w >> 1), 256);
                        float a[8], cen[8];
#pragma unroll
                        for (int q = 0; q < 8; ++q) a[q] = 0.f;
                        const bf16_t* src = XN + ((size_t)NLAT + b * 256) * D + 256 * gi + 8 * cv;
                        for (int tt = lo; tt < hi; ++tt) { const u32x4 uu = *(const u32x4*)(src + (size_t)tt * D);
                            const float f0 = bflo(uu.x), f1 = bfhi(uu.x), f2 = bflo(uu.y), f3 = bfhi(uu.y), f4 = bflo(uu.z), f5 = bfhi(uu.z), f6 = bflo(uu.w), f7 = bfhi(uu.w);
                            a[0] += f0; a[1] += f1; a[2] += f2; a[3] += f3; a[4] += f4; a[5] += f5; a[6] += f6; a[7] += f7; }
                        { const u32x4 uu = *(const u32x4*)(src + (size_t)t * D);
                            cen[0] = bflo(uu.x); cen[1] = bfhi(uu.x); cen[2] = bflo(uu.y); cen[3] = bfhi(uu.y); cen[4] = bflo(uu.z); cen[5] = bfhi(uu.z); cen[6] = bflo(uu.w); cen[7] = bfhi(uu.w); }
                        const float inv = 1.0f / (float)(hi - lo);
                        u32x4 wv; wv.x = pk2(a[0] * inv - cen[0], a[1] * inv - cen[1]); wv.y = pk2(a[2] * inv - cen[2], a[3] * inv - cen[3]);
                        wv.z = pk2(a[4] * inv - cen[4], a[5] * inv - cen[5]); wv.w = pk2(a[6] * inv - cen[6], a[7] * inv - cen[7]);
                        *(u32x4*)(Zb + ((size_t)NLAT + b * 256 + t) * D + 256 * gi + 8 * cv) = wv;
                    }
                }
            }
            GBAR();
            { pg8::Gemm gm{Zb, WPT + (size_t)j * 262144, 1024, 256, 256, 65536, 0}; S.init(128, 1, 4, nb, bid); EpiPool E{XP, P.pool_scale + j * 1024, modl,  1.0f}; pg8::gemm_phase(lds, gm, S, E); }
            if (ctx_out) { PHASE_IDS
                const float gsc =  1.0f;
                for (int item = bid; item < 256; item += nb) { const int rb = item >> 4, cb = item & 15, gi = cb >> 2;
                    ctx_tile<64, 256>(ldsf, Zb + ((size_t)NLAT + rb * 64) * D + gi * 256, D, WPT + (size_t)j * 262144 + (size_t)gi * 65536 + (size_t)(cb & 3) * 64 * 256, 256, tid);
                    __syncthreads();
#pragma unroll
                    for (int h = 0; h < 2; ++h) { const int e = tid + 512 * h, row = e >> 4, c4 = (e & 15) * 4, col = cb * 64 + c4; const f32x4 a = ctx_reduce<64>(ldsf, row, c4);
                        f32x4* xq = (f32x4*)(XC + (size_t)(rb * 64 + row) * D + col);
                        *xq = *xq + *(const f32x4*)(modl + 4 * 6144 + 2048 + col) * *(const f32x4*)(P.pool_scale + j * 1024 + col) * gsc * a; }
                    __syncthreads(); } }
            GBAR();
        }
        { PHASE_IDS
            const int nrows = ctx_out ? NROW : NLAT;
            for (int row = bid * 8 + wave; row < nrows; row += nb * 16) { const int rw1 = (row + nb * 8 < nrows) ? row + nb * 8 : row;
                const int bi0 = row < NLAT ? (row >> 13) : 4, bi1 = rw1 < NLAT ? (rw1 >> 13) : 4;
                const float* xr0 = row < NLAT ? P.out + (size_t)row * D : XC + (size_t)(row - NLAT) * D;
                const float* xr1 = rw1 < NLAT ? P.out + (size_t)rw1 * D : XC + (size_t)(rw1 - NLAT) * D;
                norm_rows2_tm(xr0, xr1, P.norm2_g + l * 1024, modl + bi0 * 6144 + 3072, modl + bi1 * 6144 + 3072, XN + (size_t)row * D, XN + (size_t)rw1 * D, lane); } }
        GBAR();
        { pg8::Gemm gm{XN, W1T + (size_t)l * 4194304, 1024, 1024, 0, 0, 0}; S.init(128, 16, 1, nb, bid); EpiM1 E{ACT, P.b1 + l * 4096}; pg8::gemm_phase(lds, gm, S, E); }
        if (ctx_out) { PHASE_IDS
            for (int item = bid; item < 256; item += nb) { const int rb = item >> 4, cb = item & 15;
#pragma unroll 1
                for (int sub = 0; sub < 4; ++sub) { const int n0 = cb * 256 + sub * 64;
                    ctx_tile<64, 1024>(ldsf, XN + ((size_t)NLAT + rb * 64) * D, D, W1T + (size_t)l * 4194304 + (size_t)n0 * 1024, 1024, tid);
                    __syncthreads();
#pragma unroll
                    for (int h = 0; h < 2; ++h) { const int e = tid + 512 * h, row = e >> 4, c4 = (e & 15) * 4, col = n0 + c4; f32x4 a = ctx_reduce<64>(ldsf, row, c4) + *(const f32x4*)(P.b1 + l * 4096 + col);
#pragma unroll
                        for (int q = 0; q < 4; ++q) { const float r = fmaxf(a[q], 0.f); a[q] = r * r; }
                        u32x2 w; w.x = pk2(a[0], a[1]); w.y = pk2(a[2], a[3]);
                        *(u32x2*)(ACT + ((size_t)NLAT + rb * 64 + row) * DFF + col) = w; }
                    __syncthreads(); } } }
        GBAR();
        { pg8::Gemm gm{ACT, W2T + (size_t)l * 4194304, 4096, 4096, 0, 0, 0}; S.init(128, 4, 1, nb, bid); EpiM2 E{XP, P.b2 + l * 1024, modl,  1.0f}; pg8::gemm_phase(lds, gm, S, E); }
        if (ctx_out) { PHASE_IDS
            const float gsc =  1.0f;
            for (int item = bid; item < 256; item += nb) { const int rb = item >> 4, cb = item & 15;
                ctx_tile<64, 4096>(ldsf, ACT + ((size_t)NLAT + rb * 64) * DFF, DFF, W2T + (size_t)l * 4194304 + (size_t)cb * 64 * 4096, 4096, tid);
                __syncthreads();
#pragma unroll
                for (int h = 0; h < 2; ++h) { const int e = tid + 512 * h, row = e >> 4, c4 = (e & 15) * 4, col = cb * 64 + c4; const f32x4 a = ctx_reduce<64>(ldsf, row, c4) + *(const f32x4*)(P.b2 + l * 1024 + col);
                    f32x4* xq = (f32x4*)(XC + (size_t)(rb * 64 + row) * D + col);
                    *xq = *xq + *(const f32x4*)(modl + 4 * 6144 + 5120 + col) * gsc * a; }
                __syncthreads(); } }
        GBAR();
    }
    { PHASE_IDS
    for (int row = bid * 8 + wave; row < NLAT; row += nb * 16) {
        const int rw1 = (row + nb * 8 < NLAT) ? row + nb * 8 : row;
        float* xr0 = P.out + (size_t)row * D; float* xr1 = P.out + (size_t)rw1 * D;
        f32x4 v0[4], v1[4]; float s0 = 0.f, s1 = 0.f;
#pragma unroll
        for (int q = 0; q < 4; ++q) { v0[q] = ((const f32x4*)xr0)[lane + 64 * q]; v1[q] = ((const f32x4*)xr1)[lane + 64 * q]; }
        f32x4 fgv[4];
#pragma unroll
        for (int q = 0; q < 4; ++q) fgv[q] = ((const f32x4*)P.final_g)[lane + 64 * q];
        __builtin_amdgcn_sched_barrier(0);
#pragma unroll
        for (int q = 0; q < 4; ++q) { s0 += (v0[q][0] * v0[q][0] + v0[q][1] * v0[q][1]) + (v0[q][2] * v0[q][2] + v0[q][3] * v0[q][3]);
            s1 += (v1[q][0] * v1[q][0] + v1[q][1] * v1[q][1]) + (v1[q][2] * v1[q][2] + v1[q][3] * v1[q][3]); }
        const float r0 = rsqrtf(wave_sum(s0) * (1.0f / D) + 1e-6f), r1 = rsqrtf(wave_sum(s1) * (1.0f / D) + 1e-6f);
#pragma unroll
        for (int q = 0; q < 4; ++q) { const f32x4 fg = fgv[q];
            ((f32x4*)xr0)[lane + 64 * q] = v0[q] * r0 * fg; if (rw1 != row) ((f32x4*)xr1)[lane + 64 * q] = v1[q] * r1 * fg; }
    } }
}

extern "C" void kernel_launch(void* const* d_in, const int* in_sizes, int n_in, void* d_out, int out_size, void* d_ws, size_t ws_size, hipStream_t stream) {
    static int grid_blocks = 0;
    if (grid_blocks == 0) {
        if (n_in != 25 || out_size != NLAT * D || ws_size < WS_END) { fprintf(stderr, "kernel_launch: unexpected shapes (n_in %d out %d ws %zu need %zu)\n", n_in, out_size, ws_size, (size_t)WS_END); grid_blocks = -1; return; }
        int dev = 0, cus = 0, per_cu = 0;
        hipGetDevice(&dev);
        hipDeviceGetAttribute(&cus, hipDeviceAttributeMultiprocessorCount, dev);
        if (hipFuncSetAttribute((const void*)fwd_kernel, hipFuncAttributeMaxDynamicSharedMemorySize, LDS_BYTES) != hipSuccess) { fprintf(stderr, "kernel_launch: hipFuncSetAttribute failed\n"); grid_blocks = -1; return; }
        hipOccupancyMaxActiveBlocksPerMultiprocessor(&per_cu, (const void*)fwd_kernel, 512, LDS_BYTES);
        if (per_cu < 1) per_cu = 1;
        grid_blocks = cus * per_cu;
    }
    if (grid_blocks < 0) return;
    Params P{};
    const float** pp = (const float**)&P;
    for (int i = 0; i < 25; ++i) pp[i] = (const float*)d_in[i];
    P.out = (float*)d_out; P.ws = (unsigned char*)d_ws;
    if (hipMemsetAsync((char*)d_ws + OFF_BAR, 0, 16384, stream) != hipSuccess) { fprintf(stderr, "kernel_launch: memset of barrier words failed\n"); return; }
    void* args[] = {&P};
    hipError_t e = hipLaunchCooperativeKernel((const void*)fwd_kernel, dim3(grid_blocks), dim3(512), args, LDS_BYTES, stream);
    if (e != hipSuccess) fprintf(stderr, "cooperative launch failed: %s (grid %d)\n", hipGetErrorString(e), grid_blocks);
}
```

```cpp
#include <hip/hip_runtime.h>
#include <hip/hip_cooperative_groups.h>
#include <cstdio>
namespace cg = cooperative_groups;

#define LAS __attribute__((address_space(3)))
typedef unsigned short bf16_t;
typedef short bf16x8 __attribute__((ext_vector_type(8)));
typedef float f32x4 __attribute__((ext_vector_type(4)));
typedef unsigned u32x4 __attribute__((ext_vector_type(4)));
typedef unsigned u32x2 __attribute__((ext_vector_type(2)));

constexpr int D = 1024, NLAT = 32768, NROW = 33792, DFF = 4096;
constexpr int CRR = 1056, CR_PAD = 1280, XS_K = 768;
constexpr int LDS_BYTES = 147456;

constexpr size_t OFF_W1 = 0;
constexpr size_t OFF_W2 = OFF_W1 + 33554432;
constexpr size_t OFF_WG = OFF_W2 + 33554432;
constexpr size_t OFF_WP = OFF_WG + 4194304;
constexpr size_t OFF_MOD = OFF_WP + 1048576;
constexpr size_t OFF_XC = OFF_MOD + 491520;
constexpr size_t OFF_XN = OFF_XC + 4194304;
constexpr size_t OFF_Z = OFF_XN + 69206016;
constexpr size_t OFF_ACT = OFF_Z + 69206016;
constexpr size_t OFF_MTAB = OFF_ACT + 276824064;
constexpr size_t OFF_BAR = OFF_MTAB + 8388608;
constexpr size_t WS_END = OFF_BAR + 16384;
constexpr size_t OFF_TC = OFF_ACT;
constexpr size_t OFF_SM = OFF_TC + 50331648;
constexpr size_t OFF_SL = OFF_SM + 16777216;
constexpr size_t OFF_XS = OFF_SL + 83886080;

struct Params {
    const float *x, *c, *ctx, *c_ctx, *ada_w, *ada_b, *norm1_g, *norm2_g, *a_re, *a_im, *log_dt, *b_re, *b_im, *c_re, *c_im, *s5_d, *glu_w, *glu_b,
        *pool_w, *pool_scale, *w1, *b1, *w2, *b2, *final_g;
    float* out;
    unsigned char* ws;
};

__device__ __forceinline__ unsigned pk2(float lo, float hi) { unsigned r; asm("v_cvt_pk_bf16_f32 %0, %1, %2" : "=v"(r) : "v"(lo), "v"(hi)); return r; }
__device__ __forceinline__ float bflo(unsigned w) { return __uint_as_float(w << 16); }
__device__ __forceinline__ float bfhi(unsigned w) { return __uint_as_float(w & 0xffff0000u); }
__device__ __forceinline__ float wave_sum(float v) {
#pragma unroll
    for (int o = 1; o < 64; o <<= 1) v += __shfl_xor(v, o);
    return v;
}
__device__ __forceinline__ float fast_exp(float x) { return __builtin_amdgcn_exp2f(x * 1.4426950408889634f); }
__device__ __forceinline__ float fast_sigmoid(float x) { return __builtin_amdgcn_rcpf(1.0f + fast_exp(-x)); }
__device__ __forceinline__ float gelu_tanh(float v) {
    const float inner = 1.5957691216057308f * (v + 0.044715f * v * v * v);
    return v * fast_sigmoid(inner);
}
__device__ __forceinline__ void cpowk(float dar, float dai, int k, float& re, float& im) {
    const float mag = fast_exp((float)k * dar);
    double rv = (double)k * (double)dai * 0.15915494309189535; rv -= __builtin_rint(rv);
    const float fr = (float)rv;
    re = mag * __builtin_amdgcn_cosf(fr); im = mag * __builtin_amdgcn_sinf(fr);
}


#define XB_TMO      128
#define XB_XCNT(j)  (256  + 64 * (j))
#define XB_XSUB(j)  (1280 + 64 * (j))
#define XB_XGEN(j)  (2304 + 64 * (j))
#define XB_TOP      3328
#define XB_TOPGEN   3392
#define XCD_BAR_WORDS 3456
#define XB_SPIN_CAP (1u << 22)
__device__ __forceinline__ unsigned xb_ld(unsigned* p)              { return __hip_atomic_load(p, __ATOMIC_RELAXED, __HIP_MEMORY_SCOPE_AGENT); }
__device__ __forceinline__ unsigned xb_add(unsigned* p, unsigned v) { return __hip_atomic_fetch_add(p, v, __ATOMIC_RELAXED, __HIP_MEMORY_SCOPE_AGENT); }
__device__ __forceinline__ unsigned xb_xcc_id() { return (unsigned)__builtin_amdgcn_s_getreg((3 << 11) | 20) & 0xFu; }
#define XB_SPIN(cond, bar) do { unsigned _sp = 0; while (cond) { __builtin_amdgcn_s_sleep(1); \
    if ((++_sp & 255u) == 0u) { if (xb_ld(&(bar)[XB_TMO])) break; if (_sp > XB_SPIN_CAP) { atomicAdd(&(bar)[XB_TMO], 1u); break; } } } } while (0)
struct XcdBarrier { unsigned* bar; unsigned x; volatile LAS unsigned* st; };
__device__ __forceinline__ XcdBarrier xcd_barrier_post(unsigned* bar, volatile LAS unsigned* st) {
    XcdBarrier b; b.bar = bar; b.x = xb_xcc_id(); b.st = st;
    if (threadIdx.x == 0) (void)xb_add(&bar[XB_XCNT(b.x)], 1u);
    return b;
}
__device__ __forceinline__ void xcd_barrier_complete(unsigned* bar, unsigned x, unsigned& nloc, unsigned& nx) {
    const unsigned G = gridDim.x * gridDim.y * gridDim.z;
    unsigned sum, cnt, mine, sp = 0u;
    for (;;) {
        sum = 0u; cnt = 0u; mine = 0u;
#pragma unroll
        for (unsigned j = 0; j < 16; ++j) { const unsigned c = xb_ld(&bar[XB_XCNT(j)]); sum += c; cnt += (c > 0u) ? 1u : 0u; mine = (j == x) ? c : mine; }
        if (sum == G) break;
        __builtin_amdgcn_s_sleep(1);
        if ((++sp & 255u) == 0u) { if (xb_ld(&bar[XB_TMO])) break; if (sp > XB_SPIN_CAP) { atomicAdd(&bar[XB_TMO], 1u); break; } }
    }
    nloc = mine > 0u ? mine : 1u; nx = cnt > 0u ? cnt : 1u;
}
__device__ __forceinline__ void xcd_barrier(const XcdBarrier& b) {
    asm volatile("s_waitcnt vmcnt(0)" ::: "memory");
    __syncthreads();
    if (threadIdx.x == 0) {
        unsigned* bar = b.bar;
        __builtin_amdgcn_s_waitcnt(0);
        unsigned nloc = b.st[0], nx = b.st[1];
        if (nloc == 0u) { xcd_barrier_complete(bar, b.x, nloc, nx); b.st[0] = nloc; b.st[1] = nx; }
        const unsigned old = xb_add(&bar[XB_XSUB(b.x)], 1u);
        const unsigned gen = old / nloc;
        if (old + 1u == (gen + 1u) * nloc) {
            __builtin_amdgcn_fence(__ATOMIC_RELEASE, "agent");
            asm volatile("s_waitcnt vmcnt(0)" ::: "memory");
            const unsigned og = xb_add(&bar[XB_TOP], 1u);
            const unsigned tg = og / nx;
            if (og + 1u == (tg + 1u) * nx) xb_add(&bar[XB_TOPGEN], 1u);
            else XB_SPIN(xb_ld(&bar[XB_TOPGEN]) == tg, bar);
            __builtin_amdgcn_fence(__ATOMIC_ACQUIRE, "agent");
            xb_add(&bar[XB_XGEN(b.x)], 1u);
            asm volatile("s_waitcnt vmcnt(0)" ::: "memory");
        } else {
            XB_SPIN(xb_ld(&bar[XB_XGEN(b.x)]) == gen, bar);
            __builtin_amdgcn_fence(__ATOMIC_ACQUIRE, "agent");
            asm volatile("s_waitcnt vmcnt(0)" ::: "memory");
        }
    }
    __syncthreads();
}

namespace pg8 {
constexpr int BM = 256, BK = 64, HALF = 128, HTB = HALF * BK * 2, NXCD = 8, WGM = 8;
__device__ __forceinline__ int lds_byte(int r, int c) { const int st = (r >> 4) * 2 + (c >> 5), rr = r & 15, cc = c & 31, ob = rr * 64 + cc * 2; return st * 1024 + (ob ^ (((ob >> 9) & 1) << 5)); }
__device__ __forceinline__ void stage_rc(int b, int& R, int& C) { const int st = b / 1024, sb = b % 1024, swz = sb ^ (((sb >> 9) & 1) << 5); R = (st >> 1) * 16 + swz / 64; C = (st & 1) * 32 + (swz % 64) / 2; }
__device__ __forceinline__ int perm32(int rho) { const int n = rho >> 4, i = rho & 15; return 8 * (i >> 2) + 4 * n + (i & 3); }

struct Unit { int pm, pn, grp; };
struct Gemm { const bf16_t* A; const bf16_t* Bt; int lda, K; long a_gs, b_gs; int a_gm; };

struct Sched {
    int nM, nN, nwg, nG, G, c, gx;
    __device__ __forceinline__ void init(int nM_, int nN_, int nG_, int G_, int c_, int gx_ = 0) { nM = nM_; nN = nN_; nwg = nM_ * nN_; nG = nG_; G = G_; c = c_; gx = gx_; }
    __device__ __forceinline__ bool next(int i, Unit& u) const {
        const long L = (long)i * G + c; if (L >= (long)nwg * nG) return false;
        if (gx && G == 256 && (nwg == 4 || nwg == 8)) {
            const int x = c & 7, q = c >> 3, gpx = 32 / nwg;
            u.grp = i * (8 * gpx) + x * gpx + q / nwg; const int w = q % nwg; u.pm = w / nN; u.pn = w % nN; return true; }
        u.grp = (int)(L / nwg); int wgid = (int)(L % nwg);
        { const int q = nwg / NXCD, r = nwg % NXCD, xcd = wgid % NXCD, off = wgid / NXCD; wgid = (xcd < r ? xcd * (q + 1) : r * (q + 1) + (xcd - r) * q) + off; }
        const int nig = WGM * nN, gid = wgid / nig, fm = gid * WGM, gsz = (nM - fm) < WGM ? (nM - fm) : WGM;
        u.pm = fm + ((wgid % nig) % gsz); u.pn = (wgid % nig) / gsz; return true;
    }
};

__device__ __forceinline__ void zero4(f32x4& v) { float a, b, c, d; asm volatile("v_mov_b32 %0, 0\n\tv_mov_b32 %1, 0\n\tv_mov_b32 %2, 0\n\tv_mov_b32 %3, 0" : "=v"(a), "=v"(b), "=v"(c), "=v"(d)); v = (f32x4){a, b, c, d}; }
template <class Epi>
__device__ __forceinline__ void gemm_phase(LAS unsigned char* lds, const Gemm g, const Sched& S, const Epi& E) {
    int tid = threadIdx.x; asm volatile("" : "+v"(tid));
    const int wid = __builtin_amdgcn_readfirstlane(tid >> 6), lane = tid & 63, wr = wid >> 2, wc = wid & 3, fr = lane & 15, fq = lane >> 4;
    int K = g.K, lda = g.lda; asm volatile("" : "+s"(K), "+s"(lda));
    const int nt = K / BK;
    unsigned voffA[2], voffB[2];
#pragma unroll
    for (int i = 0; i < 2; ++i) { int R, C; stage_rc(tid * 16 + i * 8192, R, C); const int Rb = Epi::PERM ? ((R & ~31) + perm32(R & 31)) : R;
        voffA[i] = g.a_gm ? (unsigned)(((C >> 4) * g.a_gm + R) * 16 + (C & 15)) * 2u : (unsigned)(R * lda + C) * 2u; voffB[i] = (unsigned)(Rb * K + C) * 2u; }
    const size_t kstep = (size_t)(BK * 2);
    const size_t kstepA = g.a_gm ? (size_t)g.a_gm * 128 : kstep;
    const size_t hstepA = g.a_gm ? (size_t)HALF * 32 : (size_t)HALF * lda * 2, hstepB = (size_t)HALF * K * 2;
    const size_t tstepA = 2 * hstepA, tstepB = 2 * hstepB;
    const unsigned ldsw = (unsigned)wid * 1024u;
    const int aoff = lds_byte(wr * 64 + fr, fq * 8), boff = lds_byte(wc * 32 + fr, fq * 8);
#define PG8_SA(b, h) (((b) * 2 + (h)) * HTB)
#define PG8_SB(b, h) ((4 + (b) * 2 + (h)) * HTB)
#define PG8_STAGE(bufoff, gbase, voff) do { _Pragma("unroll") for (int _i = 0; _i < 2; ++_i) \
        __builtin_amdgcn_global_load_lds((const unsigned*)((const char*)(gbase) + (voff)[_i]), (LAS unsigned*)(lds + (bufoff) + ldsw + _i * 8192), 16, 0, 0); } while (0)
#define PG8_LDA(dst, b, h) do { _Pragma("unroll") for (int m = 0; m < 4; ++m) _Pragma("unroll") for (int k = 0; k < 2; ++k) dst[m][k] = *(const LAS bf16x8*)(lds + PG8_SA(b, h) + aoff + m * 2048 + k * 1024); } while (0)
#define PG8_LDB(dst, b, h) do { _Pragma("unroll") for (int n = 0; n < 2; ++n) _Pragma("unroll") for (int k = 0; k < 2; ++k) dst[n][k] = *(const LAS bf16x8*)(lds + PG8_SB(b, h) + boff + n * 2048 + k * 1024); } while (0)
#define PG8_MMA(ai, bj, At, Bt) do { __builtin_amdgcn_s_setprio(1); _Pragma("unroll") for (int m = 0; m < 4; ++m) _Pragma("unroll") for (int n = 0; n < 2; ++n) _Pragma("unroll") for (int k = 0; k < 2; ++k) \
        acc[ai][bj][m][n] = __builtin_amdgcn_mfma_f32_16x16x32_bf16(Bt[n][k], At[m][k], acc[ai][bj][m][n], 0, 0, 0); __builtin_amdgcn_s_setprio(0); } while (0)
#define PG8_WAIT_V(n) asm volatile("s_waitcnt vmcnt(" #n ")" ::: "memory")
#define PG8_WAIT_L(n) asm volatile("s_waitcnt lgkmcnt(" #n ")" ::: "memory")
#define PG8_BAR __builtin_amdgcn_s_barrier()
#define PG8_SCHED __builtin_amdgcn_sched_barrier(0)
    Unit cur, nxt; int ui = 0;
    if (!S.next(0, cur)) return;
    f32x4 acc[2][2][4][2];
#pragma unroll
    for (int a = 0; a < 2; ++a)
#pragma unroll
        for (int b = 0; b < 2; ++b)
#pragma unroll
            for (int m = 0; m < 4; ++m)
#pragma unroll
                for (int n = 0; n < 2; ++n) zero4(acc[a][b][m][n]);
    bf16x8 At[4][2], B0[2][2], B1[2][2];
    const char* cA = (const char*)(g.A + (size_t)cur.grp * g.a_gs) + (size_t)cur.pm * tstepA;
    const char* cB = (const char*)(g.Bt + (size_t)cur.grp * g.b_gs) + (size_t)cur.pn * tstepB;
    PG8_STAGE(PG8_SB(0, 0), cB, voffB); PG8_STAGE(PG8_SA(0, 0), cA, voffA); PG8_STAGE(PG8_SB(0, 1), cB + hstepB, voffB); PG8_STAGE(PG8_SA(0, 1), cA + hstepA, voffA);
    if (wr == 1) PG8_BAR;
    PG8_WAIT_V(4); PG8_BAR;
    PG8_STAGE(PG8_SB(1, 0), cB + kstep, voffB); PG8_STAGE(PG8_SA(1, 0), cA + kstepA, voffA); PG8_STAGE(PG8_SB(1, 1), cB + hstepB + kstep, voffB);
    PG8_WAIT_V(6); PG8_BAR;
    for (;;) {
        const bool has_next = S.next(ui + 1, nxt);
        const char* nA = has_next ? (const char*)(g.A + (size_t)nxt.grp * g.a_gs) + (size_t)nxt.pm * tstepA : cA;
        const char* nB = has_next ? (const char*)(g.Bt + (size_t)nxt.grp * g.b_gs) + (size_t)nxt.pn * tstepB : cB;
        for (int t = 0; t < nt; t += 2) {
            const bool last = (t == nt - 2);
            const char* a1 = cA + (size_t)(t + 1) * kstepA;
            const char* a2 = last ? nA : cA + (size_t)(t + 2) * kstepA; const char* b2 = last ? nB : cB + (size_t)(t + 2) * kstep;
            const char* sA11 = a1 + hstepA; const char* sB00 = b2; const char* sA00 = a2; const char* sB01 = b2 + hstepB; const char* sA01 = a2 + hstepA;
            const char* sB10 = b2 + kstep; const char* sA10 = a2 + kstepA; const char* sB11 = b2 + kstep + hstepB;
            asm volatile("" : "+s"(sA11), "+s"(sB00), "+s"(sA00), "+s"(sB01)); asm volatile("" : "+s"(sA01), "+s"(sB10), "+s"(sA10), "+s"(sB11));
            PG8_LDB(B0, 0, 0); PG8_SCHED; PG8_LDA(At, 0, 0); PG8_STAGE(PG8_SA(1, 1), sA11, voffA);
            PG8_WAIT_L(8); PG8_BAR; PG8_WAIT_L(0); PG8_MMA(0, 0, At, B0); PG8_BAR; PG8_SCHED;
            PG8_LDB(B1, 0, 1); PG8_STAGE(PG8_SB(0, 0), sB00, voffB);
            PG8_BAR; PG8_WAIT_L(0); PG8_MMA(0, 1, At, B1); PG8_BAR;
            PG8_LDA(At, 0, 1); PG8_STAGE(PG8_SA(0, 0), sA00, voffA);
            PG8_BAR; PG8_WAIT_L(0); PG8_MMA(1, 0, At, B0); PG8_BAR; PG8_SCHED;
            PG8_STAGE(PG8_SB(0, 1), sB01, voffB);
            PG8_WAIT_V(6); PG8_BAR; PG8_MMA(1, 1, At, B1); PG8_BAR;
            PG8_LDB(B0, 1, 0); PG8_SCHED; PG8_LDA(At, 1, 0); PG8_STAGE(PG8_SA(0, 1), sA01, voffA);
            PG8_WAIT_L(8); PG8_BAR; PG8_WAIT_L(0); PG8_MMA(0, 0, At, B0); PG8_BAR; PG8_SCHED;
            PG8_LDB(B1, 1, 1); PG8_STAGE(PG8_SB(1, 0), sB10, voffB);
            PG8_BAR; PG8_WAIT_L(0); PG8_MMA(0, 1, At, B1); PG8_BAR;
            PG8_LDA(At, 1, 1); PG8_STAGE(PG8_SA(1, 0), sA10, voffA);
            PG8_BAR; PG8_WAIT_L(0); PG8_MMA(1, 0, At, B0); PG8_BAR; PG8_SCHED;
            PG8_STAGE(PG8_SB(1, 1), sB11, voffB);
            PG8_WAIT_V(6); PG8_BAR; PG8_MMA(1, 1, At, B1); PG8_BAR;
        }
        E(acc, cur, wr, wc, fr, fq);
        if (!has_next) break;
#pragma unroll
        for (int a = 0; a < 2; ++a)
#pragma unroll
            for (int b = 0; b < 2; ++b)
#pragma unroll
                for (int m = 0; m < 4; ++m)
#pragma unroll
                    for (int n = 0; n < 2; ++n) zero4(acc[a][b][m][n]);
        cur = nxt; cA = nA; cB = nB; ++ui;
    }
    PG8_WAIT_V(0);
    if (wr == 0) PG8_BAR;
    PG8_BAR;
#undef PG8_SA
#undef PG8_SB
#undef PG8_STAGE
#undef PG8_LDA
#undef PG8_LDB
#undef PG8_MMA
#undef PG8_WAIT_V
#undef PG8_WAIT_L
#undef PG8_BAR
#undef PG8_SCHED
}
}
using pg8::Unit;

struct XPtr { float* out; float* xc;
    __device__ __forceinline__ float* tile(int pm) const { return pm < 128 ? out + (size_t)pm * 256 * D : xc + (size_t)(pm - 128) * 256 * D; } };


#define RMW_ROWOFF(g) ((size_t)((((g) >> 2) * 128) + (((g) & 3) * 16)))
template <bool ZAUX, int CH, class F>
__device__ __forceinline__ void rmw_pipeline(float* xb, const float* xs, const bf16_t* zb, F&& f) {
    constexpr int SPG = 4 / CH, NST = 8 * SPG;
    f32x4 xv[2][CH]; u32x2 zz[2][CH];
#define RMW_ISSUE(st, s_) do { const int g_ = (st) / SPG, c0_ = ((st) % SPG) * CH; const float* rp = xs + RMW_ROWOFF(g_) * D; \
        _Pragma("unroll") for (int c = 0; c < CH; ++c) { const int cc = c0_ + c; xv[s_][c] = *(const f32x4*)(rp + (cc >> 1) * 128 + (cc & 1) * 16); \
            if (ZAUX) zz[s_][c] = *(const u32x2*)(zb + RMW_ROWOFF(g_) * 16 + (size_t)((cc >> 1) * 8 + (cc & 1)) * NROW * 16); } } while (0)
    RMW_ISSUE(0, 0); RMW_ISSUE(1, 1);
    __builtin_amdgcn_sched_barrier(0);
#pragma unroll
    for (int st = 0; st < NST; ++st) { const int s_ = st % 2, g = st / SPG, c0 = (st % SPG) * CH; float* wp = xb + RMW_ROWOFF(g) * D;
#pragma unroll
        for (int c = 0; c < CH; ++c) { const int cc = c0 + c; *(f32x4*)(wp + (cc >> 1) * 128 + (cc & 1) * 16) = f(g, cc, xv[s_][c], zz[s_][c]); }
        if (st + 2 < NST) RMW_ISSUE(st + 2, s_);
        __builtin_amdgcn_sched_barrier(0); }
#undef RMW_ISSUE
}

struct EpiM1 {
    static constexpr bool PERM = true;
    bf16_t* O; const float* bias;
    __device__ __forceinline__ void operator()(const f32x4 (&acc)[2][2][4][2], const Unit& u, int wr, int wc, int fr, int fq) const {
        const int row0 = u.pm * 256 + wr * 64 + fr, col0 = u.pn * 256 + wc * 32 + 8 * fq;
        f32x4 bv[2][2];
#pragma unroll
        for (int bj = 0; bj < 2; ++bj)
#pragma unroll
            for (int n = 0; n < 2; ++n) bv[bj][n] = *(const f32x4*)(bias + col0 + bj * 128 + 4 * n);
#pragma unroll
        for (int ai = 0; ai < 2; ++ai)
#pragma unroll
            for (int m = 0; m < 4; ++m) { bf16_t* rowp = O + (size_t)(row0 + ai * 128 + m * 16) * DFF + col0;
#pragma unroll
                for (int bj = 0; bj < 2; ++bj) { f32x4 v0 = acc[ai][bj][m][0] + bv[bj][0], v1 = acc[ai][bj][m][1] + bv[bj][1];
#pragma unroll
                    for (int j = 0; j < 4; ++j) { const float a0 = fmaxf(v0[j], 0.f), a1 = fmaxf(v1[j], 0.f); v0[j] = a0 * a0; v1[j] = a1 * a1; }
                    u32x4 w; w.x = pk2(v0[0], v0[1]); w.y = pk2(v0[2], v0[3]); w.z = pk2(v1[0], v1[1]); w.w = pk2(v1[2], v1[3]);
                    *(u32x4*)(rowp + bj * 128) = w; } }
    }
};
struct EpiM2 {
    static constexpr bool PERM = false;
    XPtr X; const float* bias; const float* modl; float gsc;
    __device__ __forceinline__ void operator()(const f32x4 (&acc)[2][2][4][2], const Unit& u, int wr, int wc, int fr, int fq) const {
        const int col0 = u.pn * 256 + wc * 32 + 4 * fq; const int bi = u.pm < 128 ? (u.pm >> 5) : 4;
        const float* gate = modl + bi * 6144 + 5120;
        float* xb = X.tile(u.pm) + (size_t)(wr * 64 + fr) * D + col0;
        f32x4 bv[2][2], gv[2][2];
#pragma unroll
        for (int bj = 0; bj < 2; ++bj)
#pragma unroll
            for (int n = 0; n < 2; ++n) { bv[bj][n] = *(const f32x4*)(bias + col0 + bj * 128 + n * 16); gv[bj][n] = *(const f32x4*)(gate + col0 + bj * 128 + n * 16) * gsc; }
        rmw_pipeline<false, 4>(xb, xb, nullptr, [&](int g, int c, f32x4 xv, u32x2) { return xv + gv[c >> 1][c & 1] * (acc[g >> 2][c >> 1][g & 3][c & 1] + bv[c >> 1][c & 1]); });
    }
};
struct EpiGLU {
    static constexpr bool PERM = false;
    XPtr X; const bf16_t* Z; const float* bias; const float* modl; float gsc; const float* xsrc;
    __device__ __forceinline__ void operator()(const f32x4 (&acc)[2][2][4][2], const Unit& u, int wr, int wc, int fr, int fq) const {
        const int col0 = u.pn * 256 + wc * 32 + 4 * fq; const int bi = u.pm < 128 ? (u.pm >> 5) : 4;
        const float* gate = modl + bi * 6144 + 2048;
        float* xb = X.tile(u.pm) + (size_t)(wr * 64 + fr) * D + col0;
        const float* xs = xsrc + ((size_t)u.pm * 256 + wr * 64 + fr) * D + col0;
        const bf16_t* zb = Z + ((size_t)(col0 >> 4) * NROW + u.pm * 256 + wr * 64 + fr) * 16 + (col0 & 15);
        f32x4 bv[2][2], gv[2][2];
#pragma unroll
        for (int bj = 0; bj < 2; ++bj)
#pragma unroll
            for (int n = 0; n < 2; ++n) { bv[bj][n] = *(const f32x4*)(bias + col0 + bj * 128 + n * 16); gv[bj][n] = *(const f32x4*)(gate + col0 + bj * 128 + n * 16) * gsc; }
        rmw_pipeline<true, 2>(xb, xs, zb, [&](int g, int c, f32x4 xv, u32x2 zz) { const f32x4 a = acc[g >> 2][c >> 1][g & 3][c & 1] + bv[c >> 1][c & 1]; f32x4 y;
            y[0] = bflo(zz.x) * fast_sigmoid(a[0]); y[1] = bfhi(zz.x) * fast_sigmoid(a[1]); y[2] = bflo(zz.y) * fast_sigmoid(a[2]); y[3] = bfhi(zz.y) * fast_sigmoid(a[3]);
            return xv + gv[c >> 1][c & 1] * y; });
    }
};
struct EpiPool {
    static constexpr bool PERM = false;
    XPtr X; const float* pscale; const float* modl; float gsc;
    __device__ __forceinline__ void operator()(const f32x4 (&acc)[2][2][4][2], const Unit& u, int wr, int wc, int fr, int fq) const {
        const int col0 = u.grp * 256 + wc * 32 + 4 * fq; const int bi = u.pm < 128 ? (u.pm >> 5) : 4;
        const float* gate = modl + bi * 6144 + 2048;
        float* xb = X.tile(u.pm) + (size_t)(wr * 64 + fr) * D + col0;
        f32x4 gv[2][2];
#pragma unroll
        for (int bj = 0; bj < 2; ++bj)
#pragma unroll
            for (int n = 0; n < 2; ++n) gv[bj][n] = *(const f32x4*)(gate + col0 + bj * 128 + n * 16) * *(const f32x4*)(pscale + col0 + bj * 128 + n * 16) * gsc;
        rmw_pipeline<false, 4>(xb, xb, nullptr, [&](int g, int c, f32x4 xv, u32x2) { return xv + gv[c >> 1][c & 1] * acc[g >> 2][c >> 1][g & 3][c & 1]; });
    }
};
struct EpiG1 {
    static constexpr bool PERM = false;
    float* SL;
    __device__ __forceinline__ void operator()(const f32x4 (&acc)[2][2][4][2], const Unit& u, int wr, int wc, int fr, int fq) const {
        float* b = SL + ((size_t)u.grp * CR_PAD + u.pm * 256 + wr * 64 + fr) * 256 + wc * 32 + 4 * fq;
#pragma unroll
        for (int ai = 0; ai < 2; ++ai)
#pragma unroll
            for (int m = 0; m < 4; ++m) { float* rowp = b + (size_t)(ai * 128 + m * 16) * 256;
#pragma unroll
                for (int bj = 0; bj < 2; ++bj)
#pragma unroll
                    for (int n = 0; n < 2; ++n) *(f32x4*)(rowp + bj * 128 + n * 16) = acc[ai][bj][m][n]; }
    }
};
struct EpiG2 {
    static constexpr bool PERM = true;
    bf16_t* Z; const bf16_t* XS; const float* dsk;
    __device__ __forceinline__ void operator()(const f32x4 (&acc)[2][2][4][2], const Unit& u, int wr, int wc, int fr, int fq) const {
        const int g = u.grp, ho0 = 8 * (fq & 1), ch = 16 * g + ho0;
#pragma unroll
        for (int ai = 0; ai < 2; ++ai)
#pragma unroll
            for (int m = 0; m < 4; ++m) { const int cr = u.pm * 256 + ai * 128 + wr * 64 + m * 16 + fr;
                if (cr < CRR) {
                    const int trow0 = cr < 1024 ? (cr >> 8) * 8192 + (cr & 255) * 32 : NLAT + (cr - 1024) * 32;
#pragma unroll
                    for (int bj = 0; bj < 2; ++bj) { const int t = 16 * u.pn + 8 * bj + 2 * wc + (fq >> 1);
                        f32x4 v0 = acc[ai][bj][m][0], v1 = acc[ai][bj][m][1];
#pragma unroll
                        for (int j = 0; j < 4; ++j) { v0[j] = gelu_tanh(v0[j]); v1[j] = gelu_tanh(v1[j]); }
                        u32x4 w; w.x = pk2(v0[0], v0[1]); w.y = pk2(v0[2], v0[3]); w.z = pk2(v1[0], v1[1]); w.w = pk2(v1[2], v1[3]);
                        *(u32x4*)(Z + ((size_t)g * NROW + trow0 + t) * 16 + ho0) = w; } } }
    }
};

__device__ __forceinline__ void transpose_item(const float* W, int K, int N, bf16_t* WT, LAS float* scr, int item, int lane) {
    const int nblk = N / 32, kb = item / nblk, nbk = item % nblk, k0 = 64 * kb, n0 = 32 * nbk;
#pragma unroll
    for (int i = 0; i < 32; ++i) { const int kk = 2 * i + (lane >> 5); scr[kk * 33 + (lane & 31)] = W[(size_t)(k0 + kk) * N + n0 + (lane & 31)]; }
    asm volatile("s_waitcnt lgkmcnt(0)" ::: "memory");
    const int c = lane & 7;
#pragma unroll
    for (int j = 0; j < 4; ++j) { const int n = (lane >> 3) + 8 * j; const LAS float* s = scr + (8 * c) * 33 + n;
        u32x4 o; o.x = pk2(s[0 * 33], s[1 * 33]); o.y = pk2(s[2 * 33], s[3 * 33]); o.z = pk2(s[4 * 33], s[5 * 33]); o.w = pk2(s[6 * 33], s[7 * 33]);
        *(u32x4*)(WT + (size_t)(n0 + n) * K + k0 + 8 * c) = o; }
    asm volatile("s_waitcnt lgkmcnt(0)" ::: "memory");
}

__device__ __forceinline__ void s5_disc(const Params& P, int j, int dir, int g, int p, float& dar, float& dai, float& kr, float& ki) {
    const int gi = (j * 2 + dir) * 64 + g, idx = gi * 64 + p;
    const float are = P.a_re[idx], aim = P.a_im[idx], dt = expf(P.log_dt[gi]);
    dar = are * dt; dai = aim * dt;
    float lr, li; cpowk(dar, dai, 1, lr, li);
    const float den = are * are + aim * aim, nr = lr - 1.0f, ni = li;
    kr = (nr * are + ni * aim) / den; ki = (ni * are - nr * aim) / den;
}

__device__ __forceinline__ void norm_row_tm(const float* xr, const float* gam, const float* sh, const float* sc, bf16_t* orow, int lane) {
    f32x4 v[4]; float ss = 0.f;
#pragma unroll
    for (int j = 0; j < 4; ++j) { v[j] = ((const f32x4*)xr)[lane + 64 * j]; ss += (v[j][0] * v[j][0] + v[j][1] * v[j][1]) + (v[j][2] * v[j][2] + v[j][3] * v[j][3]); }
    const float rstd = rsqrtf(wave_sum(ss) * (1.0f / D) + 1e-6f);
#pragma unroll
    for (int j = 0; j < 4; ++j) { const int cidx = lane + 64 * j;
        const f32x4 gg = ((const f32x4*)gam)[cidx], s1 = ((const f32x4*)sc)[cidx], s0 = ((const f32x4*)sh)[cidx];
        const f32x4 o = v[j] * rstd * gg * (s1 + 1.0f) + s0;
        u32x2 w; w.x = pk2(o[0], o[1]); w.y = pk2(o[2], o[3]);
        ((u32x2*)orow)[cidx] = w; }
}


__device__ __forceinline__ void norm_rows2_tm(const float* x0, const float* x1, const float* gam, const float* md0, const float* md1, bf16_t* o0, bf16_t* o1, int lane) {
    f32x4 v0[4], v1[4], gg[4], c0[4], h0[4], c1[4], h1[4];
#pragma unroll
    for (int j = 0; j < 4; ++j) { const int cidx = lane + 64 * j; v0[j] = ((const f32x4*)x0)[cidx]; v1[j] = ((const f32x4*)x1)[cidx]; }
#pragma unroll
    for (int j = 0; j < 4; ++j) { const int cidx = lane + 64 * j; gg[j] = ((const f32x4*)gam)[cidx];
        c0[j] = ((const f32x4*)(md0 + 1024))[cidx]; h0[j] = ((const f32x4*)md0)[cidx]; c1[j] = ((const f32x4*)(md1 + 1024))[cidx]; h1[j] = ((const f32x4*)md1)[cidx]; }
    __builtin_amdgcn_sched_barrier(0);
    float s0 = 0.f, s1 = 0.f;
#pragma unroll
    for (int j = 0; j < 4; ++j) { s0 += (v0[j][0] * v0[j][0] + v0[j][1] * v0[j][1]) + (v0[j][2] * v0[j][2] + v0[j][3] * v0[j][3]);
        s1 += (v1[j][0] * v1[j][0] + v1[j][1] * v1[j][1]) + (v1[j][2] * v1[j][2] + v1[j][3] * v1[j][3]); }
    const float r0 = rsqrtf(wave_sum(s0) * (1.0f / D) + 1e-6f), r1 = rsqrtf(wave_sum(s1) * (1.0f / D) + 1e-6f);
#pragma unroll
    for (int j = 0; j < 4; ++j) { const int cidx = lane + 64 * j;
        const f32x4 a0 = v0[j] * r0 * gg[j] * (c0[j] + 1.0f) + h0[j];
        const f32x4 a1 = v1[j] * r1 * gg[j] * (c1[j] + 1.0f) + h1[j];
        u32x2 w; w.x = pk2(a0[0], a0[1]); w.y = pk2(a0[2], a0[3]); ((u32x2*)o0)[cidx] = w;
        w.x = pk2(a1[0], a1[1]); w.y = pk2(a1[2], a1[3]); ((u32x2*)o1)[cidx] = w; }
}


template <int MT, int K>
__device__ __forceinline__ void ctx_tile(LAS float* part, const bf16_t* A, int lda, const bf16_t* Bt, int ldb, int tid, int a_gm = 0) {
    const int wave = tid >> 6, lane = tid & 63, fr = lane & 15, fq = lane >> 4;
    constexpr int MI = MT / 16;
    f32x4 acc[MI][4];
#pragma unroll
    for (int mi = 0; mi < MI; ++mi)
#pragma unroll
        for (int ni = 0; ni < 4; ++ni) acc[mi][ni] = (f32x4){0.f, 0.f, 0.f, 0.f};
    constexpr int kw = K >> 3;
    const bf16_t* a0 = A + (size_t)fr * lda + wave * kw + fq * 8;
    const bf16_t* b0 = Bt + (size_t)fr * ldb + wave * kw + fq * 8;
    bf16x8 af[2][MI], bfr[2][4];
#define CT_LOAD(buf, k) do { _Pragma("unroll") for (int mi = 0; mi < MI; ++mi) { const int kk = wave * kw + (k) + fq * 8; \
            af[buf][mi] = a_gm ? *(const bf16x8*)(A + ((size_t)(kk >> 4) * a_gm + mi * 16 + fr) * 16 + (kk & 15)) : *(const bf16x8*)(a0 + (size_t)mi * 16 * lda + (k)); } \
        _Pragma("unroll") for (int ni = 0; ni < 4; ++ni) bfr[buf][ni] = *(const bf16x8*)(b0 + (size_t)ni * 16 * ldb + (k)); } while (0)
#define CT_MMA(buf) do { _Pragma("unroll") for (int mi = 0; mi < MI; ++mi) _Pragma("unroll") for (int ni = 0; ni < 4; ++ni) \
            acc[mi][ni] = __builtin_amdgcn_mfma_f32_16x16x32_bf16(bfr[buf][ni], af[buf][mi], acc[mi][ni], 0, 0, 0); } while (0)
    CT_LOAD(0, 0);
#pragma unroll
    for (int k = 0; k < kw; k += 64) {
        if (k + 32 < kw) CT_LOAD(1, k + 32);
        __builtin_amdgcn_sched_barrier(0);
        CT_MMA(0);
        __builtin_amdgcn_sched_barrier(0);
        if (k + 64 < kw) CT_LOAD(0, k + 64);
        __builtin_amdgcn_sched_barrier(0);
        if (k + 32 < kw) CT_MMA(1);
        __builtin_amdgcn_sched_barrier(0);
    }
#undef CT_LOAD
#undef CT_MMA
    LAS float* pw = part + wave * (MT * 68);
#pragma unroll
    for (int mi = 0; mi < MI; ++mi)
#pragma unroll
        for (int ni = 0; ni < 4; ++ni) *(LAS f32x4*)(pw + (mi * 16 + fr) * 68 + ni * 16 + 4 * fq) = acc[mi][ni];
}
template <int MT>
__device__ __forceinline__ f32x4 ctx_reduce(const LAS float* part, int row, int c4) {
    f32x4 s = *(const LAS f32x4*)(part + row * 68 + c4);
#pragma unroll
    for (int w = 1; w < 8; ++w) s += *(const LAS f32x4*)(part + w * (MT * 68) + row * 68 + c4);
    return s;
}


template <int W>
__device__ __forceinline__ void pool_lat_item(const bf16_t* XN, bf16_t* Zb, LAS float* ldsf, int b, int r, int gi, int tid) {
    const int rlo = max(r - W / 2, 0), rhi = min(r + W - W / 2, 128);
#pragma unroll 1
    for (int i = 0; i < 4; ++i) { const int e = tid + 512 * i, c = e >> 5, cv = e & 31;
        const bf16_t* src = XN + ((size_t)b * 8192 + c) * D + 256 * gi + 8 * cv;
        u32x4 uu[W];
#pragma unroll
        for (int k = 0; k < W; ++k) { int rr = r - W / 2 + k; rr = rr < 0 ? 0 : (rr > 127 ? 127 : rr); uu[k] = *(const u32x4*)(src + (size_t)rr * 64 * D); }
        float a[8];
#pragma unroll
        for (int q = 0; q < 8; ++q) a[q] = 0.f;
#pragma unroll
        for (int k = 0; k < W; ++k) { const int rr = r - W / 2 + k; const float m = (rr >= 0 && rr < 128) ? 1.0f : 0.0f;
            a[0] += m * bflo(uu[k].x); a[1] += m * bfhi(uu[k].x); a[2] += m * bflo(uu[k].y); a[3] += m * bfhi(uu[k].y);
            a[4] += m * bflo(uu[k].z); a[5] += m * bfhi(uu[k].z); a[6] += m * bflo(uu[k].w); a[7] += m * bfhi(uu[k].w); }
        LAS f32x4* d4 = (LAS f32x4*)(ldsf + c * 256 + 8 * cv);
        d4[0] = (f32x4){a[0], a[1], a[2], a[3]}; d4[1] = (f32x4){a[4], a[5], a[6], a[7]}; }
    __syncthreads();
#pragma unroll 1
    for (int i = 0; i < 4; ++i) { const int e = tid + 512 * i, c = e >> 5, cv = e & 31;
        const u32x4 uc = *(const u32x4*)(XN + ((size_t)b * 8192 + r * 64 + c) * D + 256 * gi + 8 * cv);
        const int clo = max(c - W / 2, 0), chi = min(c + W - W / 2, 64);
        f32x4 t0 = (f32x4){0.f, 0.f, 0.f, 0.f}, t1 = t0;
#pragma unroll
        for (int k = 0; k < W; ++k) { const int cc = c - W / 2 + k; const int ccc = cc < 0 ? 0 : (cc > 63 ? 63 : cc); const float m = (cc >= 0 && cc < 64) ? 1.0f : 0.0f;
            const LAS f32x4* s4 = (const LAS f32x4*)(ldsf + ccc * 256 + 8 * cv); t0 += s4[0] * m; t1 += s4[1] * m; }
        const float inv = 1.0f / (float)((rhi - rlo) * (chi - clo));
        u32x4 wv; wv.x = pk2(t0[0] * inv - bflo(uc.x), t0[1] * inv - bfhi(uc.x)); wv.y = pk2(t0[2] * inv - bflo(uc.y), t0[3] * inv - bfhi(uc.y));
        wv.z = pk2(t1[0] * inv - bflo(uc.z), t1[1] * inv - bfhi(uc.z)); wv.w = pk2(t1[2] * inv - bflo(uc.w), t1[3] * inv - bfhi(uc.w));
        *(u32x4*)(Zb + ((size_t)b * 8192 + r * 64 + c) * D + 256 * gi + 8 * cv) = wv; }
    __syncthreads();
}


template <int W>
__device__ __forceinline__ void pool_band_item(const bf16_t* XN, bf16_t* Zb, LAS float* ldsf, int b, int r0, int gi, int cq, int tid) {
    constexpr int NL = W + 3;
    const int c = tid >> 3, cv = tid & 7, chb = 256 * gi + 64 * cq + 8 * cv;
    const bf16_t* src = XN + ((size_t)b * 8192 + c) * D + chb;
    u32x4 uu[NL];
#pragma unroll
    for (int k = 0; k < NL; ++k) { int rr = r0 - W / 2 + k; rr = rr < 0 ? 0 : (rr > 127 ? 127 : rr); uu[k] = *(const u32x4*)(src + (size_t)rr * 64 * D); }
#pragma unroll
    for (int k = 0; k < NL; ++k) { const int rr = r0 - W / 2 + k; if (rr < 0 || rr > 127) uu[k] = (u32x4){0u, 0u, 0u, 0u}; }
    float vs[8];
#pragma unroll
    for (int q = 0; q < 8; ++q) vs[q] = 0.f;
#pragma unroll
    for (int k = 0; k < W; ++k) { vs[0] += bflo(uu[k].x); vs[1] += bfhi(uu[k].x); vs[2] += bflo(uu[k].y); vs[3] += bfhi(uu[k].y); vs[4] += bflo(uu[k].z); vs[5] += bfhi(uu[k].z); vs[6] += bflo(uu[k].w); vs[7] += bfhi(uu[k].w); }
    const int clo = max(c - W / 2, 0), chi = min(c + W - W / 2, 64);
#pragma unroll
    for (int dr = 0; dr < 4; ++dr) {
        if (dr > 0) { const u32x4 a = uu[W - 1 + dr], o = uu[dr - 1];
            vs[0] += bflo(a.x) - bflo(o.x); vs[1] += bfhi(a.x) - bfhi(o.x); vs[2] += bflo(a.y) - bflo(o.y); vs[3] += bfhi(a.y) - bfhi(o.y);
            vs[4] += bflo(a.z) - bflo(o.z); vs[5] += bfhi(a.z) - bfhi(o.z); vs[6] += bflo(a.w) - bflo(o.w); vs[7] += bfhi(a.w) - bfhi(o.w); }
        LAS float* lbuf = ldsf + (dr & 1) * 4096;
        LAS f32x4* d4 = (LAS f32x4*)(lbuf + c * 64 + 8 * cv);
        d4[0] = (f32x4){vs[0], vs[1], vs[2], vs[3]}; d4[1] = (f32x4){vs[4], vs[5], vs[6], vs[7]};
        __syncthreads();
        const int r = r0 + dr, rlo = max(r - W / 2, 0), rhi = min(r + W - W / 2, 128);
        f32x4 t0 = (f32x4){0.f, 0.f, 0.f, 0.f}, t1 = t0;
#pragma unroll
        for (int k = 0; k < W; ++k) { const int cc = c - W / 2 + k; const int ccc = cc < 0 ? 0 : (cc > 63 ? 63 : cc); const float m = (cc >= 0 && cc < 64) ? 1.0f : 0.0f;
            const LAS f32x4* s4 = (const LAS f32x4*)(lbuf + ccc * 64 + 8 * cv); t0 += s4[0] * m; t1 += s4[1] * m; }
        const float inv = 1.0f / (float)((rhi - rlo) * (chi - clo));
        const u32x4 uc = uu[W / 2 + dr];
        u32x4 wv; wv.x = pk2(t0[0] * inv - bflo(uc.x), t0[1] * inv - bfhi(uc.x)); wv.y = pk2(t0[2] * inv - bflo(uc.y), t0[3] * inv - bfhi(uc.y));
        wv.z = pk2(t1[0] * inv - bflo(uc.z), t1[1] * inv - bfhi(uc.z)); wv.w = pk2(t1[2] * inv - bflo(uc.w), t1[3] * inv - bfhi(uc.w));
        *(u32x4*)(Zb + ((size_t)b * 8192 + r * 64 + c) * D + chb) = wv;
    }
}

__global__ void __launch_bounds__(512, 2) fwd_kernel(Params P) {
    extern __shared__ __attribute__((aligned(16))) unsigned char shm_raw[];
    LAS unsigned char* lds = (LAS unsigned char*)shm_raw;
    LAS float* ldsf = (LAS float*)lds;
    cg::grid_group grid = cg::this_grid();
    const int nb = gridDim.x, bid = blockIdx.x;
#define PHASE_IDS int tid = threadIdx.x; asm volatile("" : "+v"(tid)); const int lane = tid & 63, wave = __builtin_amdgcn_readfirstlane(tid >> 6); (void)lane; (void)wave;
    unsigned char* ws = P.ws;
    bf16_t* W1T = (bf16_t*)(ws + OFF_W1); bf16_t* W2T = (bf16_t*)(ws + OFF_W2); bf16_t* WGT = (bf16_t*)(ws + OFF_WG); bf16_t* WPT = (bf16_t*)(ws + OFF_WP);
    float* MOD = (float*)(ws + OFF_MOD); float* XC = (float*)(ws + OFF_XC);
    bf16_t* XN = (bf16_t*)(ws + OFF_XN); bf16_t* Zb = (bf16_t*)(ws + OFF_Z); bf16_t* ACT = (bf16_t*)(ws + OFF_ACT);
    float* MTAB = (float*)(ws + OFF_MTAB);
    bf16_t* TC = (bf16_t*)(ws + OFF_TC); bf16_t* SM = (bf16_t*)(ws + OFF_SM); float* SL = (float*)(ws + OFF_SL); bf16_t* XS = (bf16_t*)(ws + OFF_XS);
    const XPtr XP{P.out, XC};
    pg8::Sched S;
    volatile LAS unsigned* xb_st = (volatile LAS unsigned*)(lds + LDS_BYTES - 16);
    if (threadIdx.x == 0) { xb_st[0] = 0u; xb_st[1] = 0u; }
    __syncthreads();
    (void)xcd_barrier_post((unsigned*)(ws + OFF_BAR), xb_st);
#define GBAR() do { XcdBarrier xb_; xb_.bar = (unsigned*)(P.ws + OFF_BAR); xb_.x = xb_xcc_id(); xb_.st = (volatile LAS unsigned*)(lds + LDS_BYTES - 16); xcd_barrier(xb_); } while (0)

    {
        PHASE_IDS
        LAS float* scr = (LAS float*)(lds + wave * 8704);
        const int gw = bid * 8 + wave, NGW = nb * 8;
        for (int it = gw; it < 17664; it += NGW) {
            int r = it;
            if (r < 8192) { const int l = r >> 11; transpose_item(P.w1 + (size_t)l * 4194304, 1024, 4096, W1T + (size_t)l * 4194304, scr, r & 2047, lane); continue; }
            r -= 8192;
            if (r < 8192) { const int l = r >> 11; transpose_item(P.w2 + (size_t)l * 4194304, 4096, 1024, W2T + (size_t)l * 4194304, scr, r & 2047, lane); continue; }
            r -= 8192;
            if (r < 1024) { const int jj = r >> 9; transpose_item(P.glu_w + (size_t)jj * 1048576, 1024, 1024, WGT + (size_t)jj * 1048576, scr, r & 511, lane); continue; }
            r -= 1024;
            { const int mm = r >> 5; transpose_item(P.pool_w + (size_t)mm * 65536, 256, 256, WPT + (size_t)mm * 65536, scr, r & 31, lane); }
        }
        __syncthreads();
        LAS float* sv = ldsf;
        LAS float* red = ldsf + 5120;
        for (int i = tid; i < 5120; i += 512) { const int b = i >> 10, k = i & 1023; const float v = b < 4 ? P.c[b * 1024 + k] : P.c_ctx[k]; sv[i] = v * fast_sigmoid(v); }
        __syncthreads();
        for (int pass = bid; pass < 768; pass += nb) {
            const int gcol0 = pass * 32, l = gcol0 / 6144, n0 = gcol0 % 6144, cn = tid & 31, kq = tid >> 5;
            const float* wp = P.ada_w + ((size_t)l * 1024 + kq * 64) * 6144 + n0 + cn;
            float a0 = 0.f, a1 = 0.f, a2 = 0.f, a3 = 0.f, a4 = 0.f;
#pragma unroll 16
            for (int kk = 0; kk < 64; ++kk) { const float w = wp[(size_t)kk * 6144]; const int k = kq * 64 + kk;
                a0 += sv[k] * w; a1 += sv[1024 + k] * w; a2 += sv[2048 + k] * w; a3 += sv[3072 + k] * w; a4 += sv[4096 + k] * w; }
            red[(kq * 5 + 0) * 32 + cn] = a0; red[(kq * 5 + 1) * 32 + cn] = a1; red[(kq * 5 + 2) * 32 + cn] = a2; red[(kq * 5 + 3) * 32 + cn] = a3; red[(kq * 5 + 4) * 32 + cn] = a4;
            __syncthreads();
            if (tid < 160) { const int b = tid >> 5, c2 = tid & 31; float s = P.ada_b[l * 6144 + n0 + c2];
#pragma unroll
                for (int q = 0; q < 16; ++q) s += red[(q * 5 + b) * 32 + c2];
                MOD[(size_t)(l * 5 + b) * 6144 + n0 + c2] = s; }
            __syncthreads();
        }
        LAS float* Bbr = ldsf;
        LAS float* Bbi = ldsf + 1024;
        LAS float* Ctr = ldsf + 2048;
        LAS float* Cti = ldsf + 3072;
        LAS float* pwr = ldsf + 4096;
        LAS float* pwi = ldsf + 4096 + 2112;
        for (int item = bid; item < 256; item += nb) {
            const int dir = item & 1, g = (item >> 1) & 63, j = item >> 7;
            if (tid < 64) { const int p = tid; float dar, dai, kr, ki; s5_disc(P, j, dir, g, p, dar, dai, kr, ki);
                for (int k = 0; k < 32; ++k) { float re, im; cpowk(dar, dai, k, re, im); pwr[p * 33 + k] = re; pwi[p * 33 + k] = im; }
                const size_t bb = ((size_t)((j * 2 + dir) * 64 + g) * 64 + p) * 16;
#pragma unroll
                for (int h = 0; h < 16; ++h) { const float br = P.b_re[bb + h], bi2 = P.b_im[bb + h]; Bbr[p * 16 + h] = kr * br - ki * bi2; Bbi[p * 16 + h] = kr * bi2 + ki * br; } }
            for (int e = tid; e < 1024; e += 512) { const int ho = e >> 6, p = e & 63; const size_t ci = ((size_t)((j * 2 + dir) * 64 + g) * 16 + ho) * 64 + p;
                Ctr[p * 16 + ho] = P.c_re[ci]; Cti[p * 16 + ho] = P.c_im[ci]; }
            __syncthreads();
            { const int k = tid >> 4, ho = tid & 15; float a[16];
#pragma unroll
                for (int h = 0; h < 16; ++h) a[h] = 0.f;
                for (int p = 0; p < 64; ++p) { const float cr = Ctr[p * 16 + ho], ci = Cti[p * 16 + ho], pr = pwr[p * 33 + k], pi = pwi[p * 33 + k];
                    const float cpr = cr * pr - ci * pi, cpi = cr * pi + ci * pr;
                    const LAS f32x4* br4 = (const LAS f32x4*)(Bbr + p * 16); const LAS f32x4* bi4 = (const LAS f32x4*)(Bbi + p * 16);
#pragma unroll
                    for (int q = 0; q < 4; ++q) { const f32x4 br = br4[q], bi2 = bi4[q];
#pragma unroll
                        for (int e = 0; e < 4; ++e) a[q * 4 + e] += cpr * br[e] - cpi * bi2[e]; } }
                float* mo = MTAB + ((size_t)((j * 64 + g) * 2 + dir) * 32 + k) * 256 + ho * 16;
#pragma unroll
                for (int q = 0; q < 4; ++q) ((f32x4*)mo)[q] = (f32x4){a[q * 4], a[q * 4 + 1], a[q * 4 + 2], a[q * 4 + 3]}; }
            __syncthreads();
        }
    }
    if (P.ws == nullptr) grid.sync();
    GBAR();

#pragma unroll 1
    for (int l = 0; l < 4; ++l) {
        const int j = l >> 1;
        const bool ctx_out = l < 2;
        const float* modl = MOD + (size_t)l * 5 * 6144;
        if ((l & 1) == 0) {
            {
                PHASE_IDS
                LAS float* Bbr = ldsf;
                LAS float* Bbi = ldsf + 2048;
                LAS float* Cr = ldsf + 4096;
                LAS float* Ci = ldsf + 6144;
                LAS float* pwr = ldsf + 8192;
                LAS float* pwi = ldsf + 8192 + 4224;
                const int nit = (256 + CRR - bid + nb - 1) / nb;
                for (int kq = 0; kq < nit; ++kq) {
                    const int kk = (bid & 1) ? (kq + 1 == nit ? 0 : kq + 1) : kq; const int item = bid + kk * nb;
                    if (item < 256) {
                        const int g = item >> 2, q4 = item & 3;
                        if (tid < 128) { const int dir = tid >> 6, p = tid & 63; float dar, dai, kr, ki; s5_disc(P, j, dir, g, p, dar, dai, kr, ki);
                            for (int k = 0; k < 33; ++k) { float re, im; cpowk(dar, dai, k, re, im); pwr[(dir * 33 + k) * 64 + p] = re; pwi[(dir * 33 + k) * 64 + p] = im; }
                            const size_t bb = ((size_t)((j * 2 + dir) * 64 + g) * 64 + p) * 16;
#pragma unroll
                            for (int h = 0; h < 16; ++h) { const float br = P.b_re[bb + h], bi2 = P.b_im[bb + h]; Bbr[(dir * 64 + p) * 16 + h] = kr * br - ki * bi2; Bbi[(dir * 64 + p) * 16 + h] = kr * bi2 + ki * br; } }
                        for (int e = tid; e < 2048; e += 512) { const int dir = e >> 10, r2 = e & 1023; const size_t ci = (size_t)((j * 2 + dir) * 64 + g) * 1024 + r2;
                            Cr[e] = P.c_re[ci]; Ci[e] = P.c_im[ci]; }
                        LAS float* Ml = ldsf + 16640;
                        { const f32x4* msrc = (const f32x4*)(MTAB + (size_t)((j * 64 + g) * 2 + 0) * 8192);
#pragma unroll
                            for (int q = 0; q < 8; ++q) { const int e = tid + 512 * q; *(LAS f32x4*)(Ml + (e >> 6) * 260 + (e & 63) * 4) = msrc[e]; } }
                        __syncthreads();
                        const LAS float* Mf = Ml; const LAS float* Mb = Ml + 32 * 260;
                        const float dsk_ho_base = 0.f; (void)dsk_ho_base;
                        for (int e = tid; e < 12288; e += 512) { const int nl = e / 96, kv = e % 96, n = 128 * q4 + nl, t = n >> 4, ho = n & 15, k0 = kv * 8;
                            float v[8];
                            if (k0 < 512) { const int s = k0 >> 4, hi0 = k0 & 15;
#pragma unroll
                                for (int i = 0; i < 8; ++i) v[i] = 0.f;
                                if (t >= s) { const f32x4 m0 = *(const LAS f32x4*)(Mf + (t - s) * 260 + ho * 16 + hi0), m1 = *(const LAS f32x4*)(Mf + (t - s) * 260 + ho * 16 + hi0 + 4);
#pragma unroll
                                    for (int i = 0; i < 4; ++i) { v[i] += m0[i]; v[4 + i] += m1[i]; } }
                                if (s >= t) { const f32x4 m0 = *(const LAS f32x4*)(Mb + (s - t) * 260 + ho * 16 + hi0), m1 = *(const LAS f32x4*)(Mb + (s - t) * 260 + ho * 16 + hi0 + 4);
#pragma unroll
                                    for (int i = 0; i < 4; ++i) { v[i] += m0[i]; v[4 + i] += m1[i]; } }
                                if (s == t) { const float dsk = P.s5_d[j * 1024 + 16 * g + ho];
#pragma unroll
                                    for (int i = 0; i < 8; ++i) v[i] += (hi0 + i == ho) ? dsk : 0.f; }
                            } else { const int q = k0 - 512, dir = q >> 7, part = (q >> 6) & 1, p0 = q & 63, ee = dir ? 32 - t : t + 1;
#pragma unroll
                                for (int i = 0; i < 8; ++i) { const int p = p0 + i; const float cr = Cr[(dir * 16 + ho) * 64 + p], ci = Ci[(dir * 16 + ho) * 64 + p], pr = pwr[(dir * 33 + ee) * 64 + p], pi = pwi[(dir * 33 + ee) * 64 + p];
                                    v[i] = part ? -(cr * pi + ci * pr) : (cr * pr - ci * pi); } }
                            u32x4 w; w.x = pk2(v[0], v[1]); w.y = pk2(v[2], v[3]); w.z = pk2(v[4], v[5]); w.w = pk2(v[6], v[7]);
                            *(u32x4*)(TC + ((size_t)g * 512 + n) * XS_K + k0) = w; }
                        for (int e = tid; e < 4096; e += 512) { const int ql = e >> 6, kv = e & 63, q = 64 * q4 + ql, dir = q >> 7, part = (q >> 6) & 1, p = q & 63, k0 = kv * 8, s = k0 >> 4, hi0 = k0 & 15, ee = dir ? s : 31 - s;
                            const float pr = pwr[(dir * 33 + ee) * 64 + p], pi = pwi[(dir * 33 + ee) * 64 + p];
                            float v[8];
#pragma unroll
                            for (int i = 0; i < 8; ++i) { const float br = Bbr[(dir * 64 + p) * 16 + hi0 + i], bi2 = Bbi[(dir * 64 + p) * 16 + hi0 + i]; v[i] = part ? (pr * bi2 + pi * br) : (pr * br - pi * bi2); }
                            u32x4 w; w.x = pk2(v[0], v[1]); w.y = pk2(v[2], v[3]); w.z = pk2(v[4], v[5]); w.w = pk2(v[6], v[7]);
                            *(u32x4*)(SM + ((size_t)g * 256 + q) * 512 + k0) = w; }
                        __syncthreads();
                    } else {
                        const int cr = item - 256; const int bi = cr < 1024 ? (cr >> 8) : 4;
                        const int row0 = cr < 1024 ? (cr >> 8) * 8192 + (cr & 255) * 32 : NLAT + (cr - 1024) * 32;
                        const float* gam = P.norm1_g + l * 1024 + 16 * lane; const float* shp = modl + bi * 6144 + 16 * lane; const float* scp = shp + 1024;
                        f32x4 gs[4], sh[4];
#pragma unroll
                        for (int q = 0; q < 4; ++q) { gs[q] = ((const f32x4*)gam)[q] * (((const f32x4*)scp)[q] + 1.0f); sh[q] = ((const f32x4*)shp)[q]; }
                        {
                            f32x4 v[4][4]; float ss[4];
#pragma unroll
                            for (int r = 0; r < 4; ++r) { const int row = row0 + wave + 8 * r;
                                const float* src = (l == 0) ? (row < NLAT ? P.x + (size_t)row * D : P.ctx + (size_t)(row - NLAT) * D) : (row < NLAT ? P.out + (size_t)row * D : XC + (size_t)(row - NLAT) * D);
#pragma unroll
                                for (int q = 0; q < 4; ++q) v[r][q] = ((const f32x4*)(src + 16 * lane))[q]; }
                            __builtin_amdgcn_sched_barrier(0);
#pragma unroll
                            for (int r = 0; r < 4; ++r) { ss[r] = 0.f;
#pragma unroll
                                for (int q = 0; q < 4; ++q) ss[r] += (v[r][q][0] * v[r][q][0] + v[r][q][1] * v[r][q][1]) + (v[r][q][2] * v[r][q][2] + v[r][q][3] * v[r][q][3]); }
#pragma unroll
                            for (int r = 0; r < 4; ++r) { const int t = wave + 8 * r;
                                const float rstd = rsqrtf(wave_sum(ss[r]) * (1.0f / D) + 1e-6f);
                                u32x4 w0, w1; f32x4 o;
                                o = v[r][0] * rstd * gs[0] + sh[0]; w0.x = pk2(o[0], o[1]); w0.y = pk2(o[2], o[3]);
                                o = v[r][1] * rstd * gs[1] + sh[1]; w0.z = pk2(o[0], o[1]); w0.w = pk2(o[2], o[3]);
                                o = v[r][2] * rstd * gs[2] + sh[2]; w1.x = pk2(o[0], o[1]); w1.y = pk2(o[2], o[3]);
                                o = v[r][3] * rstd * gs[3] + sh[3]; w1.z = pk2(o[0], o[1]); w1.w = pk2(o[2], o[3]);
                                LAS u32x4* dq = (LAS u32x4*)(lds + lane * 1040 + t * 32);
                                dq[0] = w0; dq[1] = w1; } }
                        __syncthreads();
#pragma unroll
                        for (int gq = 0; gq < 8; ++gq) { const int g = wave * 8 + gq;
                            const u32x4 w = *(const LAS u32x4*)(lds + g * 1040 + lane * 16);
                            *(u32x4*)(XS + ((size_t)g * CRR + cr) * XS_K + lane * 8) = w; }
                        __syncthreads();
                    }
                }
            }
            GBAR();
            { pg8::Gemm gm{XS, SM, XS_K, 512, (long)CRR * XS_K, 256L * 512, 0}; S.init(4, 1, 64, nb, bid, 1); EpiG1 E{SL}; pg8::gemm_phase(lds, gm, S, E); }
            { PHASE_IDS
                for (int item = bid; item < 256; item += nb) { const int g = item >> 2, q = item & 3;
                    ctx_tile<32, 512>(ldsf, XS + ((size_t)g * CRR + 1024) * XS_K, XS_K, SM + ((size_t)g * 256 + q * 64) * 512, 512, tid);
                    __syncthreads();
                    { const int row = tid >> 4, c4 = (tid & 15) * 4; const f32x4 v = ctx_reduce<32>(ldsf, row, c4);
                        *(f32x4*)(SL + ((size_t)g * CR_PAD + 1024 + row) * 256 + q * 64 + c4) = v; }
                    __syncthreads(); } }
            GBAR();
            {
                PHASE_IDS
                LAS float* er = ldsf; LAS float* ei = ldsf + 512;
                for (int item = bid; item < 512; item += nb) {
                    const int dir = item & 1, g = (item >> 1) & 63, b = item >> 7, p = lane, seg = wave;
                    float dar, dai, kr, ki; s5_disc(P, j, dir, g, p, dar, dai, kr, ki);
                    float Ar, Ai, A33r, A33i; cpowk(dar, dai, 32, Ar, Ai); cpowk(dar, dai, 32 * 33, A33r, A33i);
                    const float* sl = SL + (size_t)g * CR_PAD * 256 + dir * 128 + p;
                    float vr[33], vi[33];
#pragma unroll
                    for (int jj = 0; jj < 33; ++jj) { const int i = seg * 33 + jj; const int cr = i < 8 ? 1024 + b * 8 + (dir ? 7 - i : i) : b * 256 + (dir ? 263 - i : i - 8);
                        vr[jj] = sl[(size_t)cr * 256]; vi[jj] = sl[(size_t)cr * 256 + 64]; }
#pragma unroll
                    for (int jj = 1; jj < 33; ++jj) { const float nr = Ar * vr[jj - 1] - Ai * vi[jj - 1] + vr[jj], ni = Ar * vi[jj - 1] + Ai * vr[jj - 1] + vi[jj]; vr[jj] = nr; vi[jj] = ni; }
                    er[seg * 64 + p] = vr[32]; ei[seg * 64 + p] = vi[32];
                    __syncthreads();
                    float cr_ = 0.f, ci_ = 0.f;
                    for (int s2 = 0; s2 < seg; ++s2) { const float nr = A33r * cr_ - A33i * ci_ + er[s2 * 64 + p], ni = A33r * ci_ + A33i * cr_ + ei[s2 * 64 + p]; cr_ = nr; ci_ = ni; }
                    __syncthreads();
                    bf16_t* xo = XS + (size_t)g * CRR * XS_K + 512 + dir * 128 + p;
#pragma unroll
                    for (int jj = 0; jj < 33; ++jj) { const int i = seg * 33 + jj; const int cr = i < 8 ? 1024 + b * 8 + (dir ? 7 - i : i) : b * 256 + (dir ? 263 - i : i - 8);
                        const float orr = jj == 0 ? cr_ : vr[jj - 1] + cr_, oi = jj == 0 ? ci_ : vi[jj - 1] + ci_;
                        const unsigned w = pk2(orr, oi);
                        xo[(size_t)cr * XS_K] = (bf16_t)(w & 0xffffu); xo[(size_t)cr * XS_K + 64] = (bf16_t)(w >> 16);
                        const float nr = Ar * cr_ - Ai * ci_, ni = Ar * ci_ + Ai * cr_; cr_ = nr; ci_ = ni; }
                }
            }
            GBAR();
            { pg8::Gemm gm{XS, TC, XS_K, XS_K, (long)CRR * XS_K, 512L * XS_K, 0}; S.init(4, 2, 64, nb, bid, 1); EpiG2 E{Zb, XS, P.s5_d + j * 1024}; pg8::gemm_phase(lds, gm, S, E); }
            if (ctx_out) { PHASE_IDS
                for (int item = bid; item < 512; item += nb) { const int g = item >> 3, q = item & 7;
                    ctx_tile<32, 768>(ldsf, XS + ((size_t)g * CRR + 1024) * XS_K, XS_K, TC + ((size_t)g * 512 + q * 64) * XS_K, XS_K, tid);
                    __syncthreads();
                    { const int row = tid >> 4, c4 = (tid & 15) * 4; f32x4 v = ctx_reduce<32>(ldsf, row, c4);
                        const int n = q * 64 + c4, t = n >> 4, ho = n & 15, ch = 16 * g + ho;
                        v[0] = gelu_tanh(v[0]); v[1] = gelu_tanh(v[1]); v[2] = gelu_tanh(v[2]); v[3] = gelu_tanh(v[3]);
                        u32x2 w; w.x = pk2(v[0], v[1]); w.y = pk2(v[2], v[3]);
                        *(u32x2*)(Zb + ((size_t)g * NROW + NLAT + row * 32 + t) * 16 + ho) = w; }
                    __syncthreads(); } }
            GBAR();
            { pg8::Gemm gm{Zb, WGT + (size_t)j * 1048576, 1024, 1024, 0, 0, NROW}; S.init(128, 4, 1, nb, bid); EpiGLU E{XP, Zb, P.glu_b + j * 1024, modl,  1.0f, l == 0 ? P.x : P.out}; pg8::gemm_phase(lds, gm, S, E); }
            if (ctx_out) { PHASE_IDS
                const float gsc =  1.0f;
                for (int item = bid; item < 256; item += nb) { const int rb = item >> 4, cb = item & 15;
                    ctx_tile<64, 1024>(ldsf, Zb + ((size_t)NLAT + rb * 64) * 16, D, WGT + (size_t)j * 1048576 + (size_t)cb * 64 * 1024, 1024, tid, NROW);
                    __syncthreads();
#pragma unroll
                    for (int h = 0; h < 2; ++h) { const int e = tid + 512 * h, row = e >> 4, c4 = (e & 15) * 4, col = cb * 64 + c4; const f32x4 a = ctx_reduce<64>(ldsf, row, c4) + *(const f32x4*)(P.glu_b + j * 1024 + col);
                        const u32x2 zz = *(const u32x2*)(Zb + ((size_t)(col >> 4) * NROW + NLAT + rb * 64 + row) * 16 + (col & 15));
                        f32x4 y; y[0] = bflo(zz.x) * fast_sigmoid(a[0]); y[1] = bfhi(zz.x) * fast_sigmoid(a[1]); y[2] = bflo(zz.y) * fast_sigmoid(a[2]); y[3] = bfhi(zz.y) * fast_sigmoid(a[3]);
                        f32x4* xq = (f32x4*)(XC + (size_t)(rb * 64 + row) * D + col);
                        const f32x4 xv = *(const f32x4*)((l == 0 ? P.ctx : XC) + (size_t)(rb * 64 + row) * D + col);
                        *xq = xv + *(const f32x4*)(modl + 4 * 6144 + 2048 + col) * gsc * y; }
                    __syncthreads(); } }
            GBAR();
        } else {
            { PHASE_IDS
                const int nrows = ctx_out ? NROW : NLAT;
                for (int row = bid * 8 + wave; row < nrows; row += nb * 16) { const int rw1 = (row + nb * 8 < nrows) ? row + nb * 8 : row;
                    const int bi0 = row < NLAT ? (row >> 13) : 4, bi1 = rw1 < NLAT ? (rw1 >> 13) : 4;
                    const float* xr0 = row < NLAT ? P.out + (size_t)row * D : XC + (size_t)(row - NLAT) * D;
                    const float* xr1 = rw1 < NLAT ? P.out + (size_t)rw1 * D : XC + (size_t)(rw1 - NLAT) * D;
                    norm_rows2_tm(xr0, xr1, P.norm1_g + l * 1024, modl + bi0 * 6144, modl + bi1 * 6144, XN + (size_t)row * D, XN + (size_t)rw1 * D, lane); } }
            GBAR();
            {
                PHASE_IDS
                const int nitems = 2048 + (ctx_out ? 256 : 0);
                for (int item = bid; item < nitems; item += nb) {
                    if (item < 2048) {
                        const int rest = item >> 2, gi = ((item & 3) + (item >> 8)) & 3, cq = rest & 3, r0 = ((rest >> 2) & 31) * 4, b = rest >> 7;
                        if (gi == 0) pool_band_item<2>(XN, Zb, ldsf, b, r0, gi, cq, tid);
                        else if (gi == 1) pool_band_item<4>(XN, Zb, ldsf, b, r0, gi, cq, tid);
                        else if (gi == 2) pool_band_item<8>(XN, Zb, ldsf, b, r0, gi, cq, tid);
                        else pool_band_item<16>(XN, Zb, ldsf, b, r0, gi, cq, tid);
                    } else {
                        const int ci = item - 2048, gi = ci & 3, tb = (ci >> 2) & 15, b = ci >> 6, w = 2 << gi;
                        const int t = tb * 16 + (tid >> 5), cv = tid & 31;
                        const int lo = max(t - (w >> 1), 0), hi = min(t + w - (w >> 1), 256);
                        float a[8], cen[8];
#pragma unroll
                        for (int q = 0; q < 8; ++q) a[q] = 0.f;
                        const bf16_t* src = XN + ((size_t)NLAT + b * 256) * D + 256 * gi + 8 * cv;
                        for (int tt = lo; tt < hi; ++tt) { const u32x4 uu = *(const u32x4*)(src + (size_t)tt * D);
                            const float f0 = bflo(uu.x), f1 = bfhi(uu.x), f2 = bflo(uu.y), f3 = bfhi(uu.y), f4 = bflo(uu.z), f5 = bfhi(uu.z), f6 = bflo(uu.w), f7 = bfhi(uu.w);
                            a[0] += f0; a[1] += f1; a[2] += f2; a[3] += f3; a[4] += f4; a[5] += f5; a[6] += f6; a[7] += f7; }
                        { const u32x4 uu = *(const u32x4*)(src + (size_t)t * D);
                            cen[0] = bflo(uu.x); cen[1] = bfhi(uu.x); cen[2] = bflo(uu.y); cen[3] = bfhi(uu.y); cen[4] = bflo(uu.z); cen[5] = bfhi(uu.z); cen[6] = bflo(uu.w); cen[7] = bfhi(uu.w); }
                        const float inv = 1.0f / (float)(hi - lo);
                        u32x4 wv; wv.x = pk2(a[0] * inv - cen[0], a[1] * inv - cen[1]); wv.y = pk2(a[2] * inv - cen[2], a[3] * inv - cen[3]);
                        wv.z = pk2(a[4] * inv - cen[4], a[5] * inv - cen[5]); wv.w = pk2(a[6] * inv - cen[6], a[7] * inv - cen[7]);
                        *(u32x4*)(Zb + ((size_t)NLAT + b * 256 + t) * D + 256 * gi + 8 * cv) = wv;
                    }
                }
            }
            GBAR();
            { pg8::Gemm gm{Zb, WPT + (size_t)j * 262144, 1024, 256, 256, 65536, 0}; S.init(128, 1, 4, nb, bid); EpiPool E{XP, P.pool_scale + j * 1024, modl,  1.0f}; pg8::gemm_phase(lds, gm, S, E); }
            if (ctx_out) { PHASE_IDS
                const float gsc =  1.0f;
                for (int item = bid; item < 256; item += nb) { const int rb = item >> 4, cb = item & 15, gi = cb >> 2;
                    ctx_tile<64, 256>(ldsf, Zb + ((size_t)NLAT + rb * 64) * D + gi * 256, D, WPT + (size_t)j * 262144 + (size_t)gi * 65536 + (size_t)(cb & 3) * 64 * 256, 256, tid);
                    __syncthreads();
#pragma unroll
                    for (int h = 0; h < 2; ++h) { const int e = tid + 512 * h, row = e >> 4, c4 = (e & 15) * 4, col = cb * 64 + c4; const f32x4 a = ctx_reduce<64>(ldsf, row, c4);
                        f32x4* xq = (f32x4*)(XC + (size_t)(rb * 64 + row) * D + col);
                        *xq = *xq + *(const f32x4*)(modl + 4 * 6144 + 2048 + col) * *(const f32x4*)(P.pool_scale + j * 1024 + col) * gsc * a; }
                    __syncthreads(); } }
            GBAR();
        }
        { PHASE_IDS
            const int nrows = ctx_out ? NROW : NLAT;
            for (int row = bid * 8 + wave; row < nrows; row += nb * 16) { const int rw1 = (row + nb * 8 < nrows) ? row + nb * 8 : row;
                const int bi0 = row < NLAT ? (row >> 13) : 4, bi1 = rw1 < NLAT ? (rw1 >> 13) : 4;
                const float* xr0 = row < NLAT ? P.out + (size_t)row * D : XC + (size_t)(row - NLAT) * D;
                const float* xr1 = rw1 < NLAT ? P.out + (size_t)rw1 * D : XC + (size_t)(rw1 - NLAT) * D;
                norm_rows2_tm(xr0, xr1, P.norm2_g + l * 1024, modl + bi0 * 6144 + 3072, modl + bi1 * 6144 + 3072, XN + (size_t)row * D, XN + (size_t)rw1 * D, lane); } }
        GBAR();
        { pg8::Gemm gm{XN, W1T + (size_t)l * 4194304, 1024, 1024, 0, 0, 0}; S.init(128, 16, 1, nb, bid); EpiM1 E{ACT, P.b1 + l * 4096}; pg8::gemm_phase(lds, gm, S, E); }
        if (ctx_out) { PHASE_IDS
            for (int item = bid; item < 256; item += nb) { const int rb = item >> 4, cb = item & 15;
#pragma unroll 1
                for (int sub = 0; sub < 4; ++sub) { const int n0 = cb * 256 + sub * 64;
                    ctx_tile<64, 1024>(ldsf, XN + ((size_t)NLAT + rb * 64) * D, D, W1T + (size_t)l * 4194304 + (size_t)n0 * 1024, 1024, tid);
                    __syncthreads();
#pragma unroll
                    for (int h = 0; h < 2; ++h) { const int e = tid + 512 * h, row = e >> 4, c4 = (e & 15) * 4, col = n0 + c4; f32x4 a = ctx_reduce<64>(ldsf, row, c4) + *(const f32x4*)(P.b1 + l * 4096 + col);
#pragma unroll
                        for (int q = 0; q < 4; ++q) { const float r = fmaxf(a[q], 0.f); a[q] = r * r; }
                        u32x2 w; w.x = pk2(a[0], a[1]); w.y = pk2(a[2], a[3]);
                        *(u32x2*)(ACT + ((size_t)NLAT + rb * 64 + row) * DFF + col) = w; }
                    __syncthreads(); } } }
        GBAR();
        { pg8::Gemm gm{ACT, W2T + (size_t)l * 4194304, 4096, 4096, 0, 0, 0}; S.init(128, 4, 1, nb, bid); EpiM2 E{XP, P.b2 + l * 1024, modl,  1.0f}; pg8::gemm_phase(lds, gm, S, E); }
        if (ctx_out) { PHASE_IDS
            const float gsc =  1.0f;
            for (int item = bid; item < 256; item += nb) { const int rb = item >> 4, cb = item & 15;
                ctx_tile<64, 4096>(ldsf, ACT + ((size_t)NLAT + rb * 64) * DFF, DFF, W2T + (size_t)l * 4194304 + (size_t)cb * 64 * 4096, 4096, tid);
                __syncthreads();
#pragma unroll
                for (int h = 0; h < 2; ++h) { const int e = tid + 512 * h, row = e >> 4, c4 = (e & 15) * 4, col = cb * 64 + c4; const f32x4 a = ctx_reduce<64>(ldsf, row, c4) + *(const f32x4*)(P.b2 + l * 1024 + col);
                    f32x4* xq = (f32x4*)(XC + (size_t)(rb * 64 + row) * D + col);
                    *xq = *xq + *(const f32x4*)(modl + 4 * 6144 + 5120 + col) * gsc * a; }
                __syncthreads(); } }
        GBAR();
    }
    { PHASE_IDS
    for (int row = bid * 8 + wave; row < NLAT; row += nb * 16) {
        const int rw1 = (row + nb * 8 < NLAT) ? row + nb * 8 : row;
        float* xr0 = P.out + (size_t)row * D; float* xr1 = P.out + (size_t)rw1 * D;
        f32x4 v0[4], v1[4]; float s0 = 0.f, s1 = 0.f;
#pragma unroll
        for (int q = 0; q < 4; ++q) { v0[q] = ((const f32x4*)xr0)[lane + 64 * q]; v1[q] = ((const f32x4*)xr1)[lane + 64 * q]; }
        f32x4 fgv[4];
#pragma unroll
        for (int q = 0; q < 4; ++q) fgv[q] = ((const f32x4*)P.final_g)[lane + 64 * q];
        __builtin_amdgcn_sched_barrier(0);
#pragma unroll
        for (int q = 0; q < 4; ++q) { s0 += (v0[q][0] * v0[q][0] + v0[q][1] * v0[q][1]) + (v0[q][2] * v0[q][2] + v0[q][3] * v0[q][3]);
            s1 += (v1[q][0] * v1[q][0] + v1[q][1] * v1[q][1]) + (v1[q][2] * v1[q][2] + v1[q][3] * v1[q][3]); }
        const float r0 = rsqrtf(wave_sum(s0) * (1.0f / D) + 1e-6f), r1 = rsqrtf(wave_sum(s1) * (1.0f / D) + 1e-6f);
#pragma unroll
        for (int q = 0; q < 4; ++q) { const f32x4 fg = fgv[q];
            ((f32x4*)xr0)[lane + 64 * q] = v0[q] * r0 * fg; if (rw1 != row) ((f32x4*)xr1)[lane + 64 * q] = v1[q] * r1 * fg; }
    } }
}

extern "C" void kernel_launch(void* const* d_in, const int* in_sizes, int n_in, void* d_out, int out_size, void* d_ws, size_t ws_size, hipStream_t stream) {
    static int grid_blocks = 0;
    if (grid_blocks == 0) {
        if (n_in != 25 || out_size != NLAT * D || ws_size < WS_END) { fprintf(stderr, "kernel_launch: unexpected shapes (n_in %d out %d ws %zu need %zu)\n", n_in, out_size, ws_size, (size_t)WS_END); grid_blocks = -1; return; }
        int dev = 0, cus = 0, per_cu = 0;
        hipGetDevice(&dev);
        hipDeviceGetAttribute(&cus, hipDeviceAttributeMultiprocessorCount, dev);
        if (hipFuncSetAttribute((const void*)fwd_kernel, hipFuncAttributeMaxDynamicSharedMemorySize, LDS_BYTES) != hipSuccess) { fprintf(stderr, "kernel_launch: hipFuncSetAttribute failed\n"); grid_blocks = -1; return; }
        hipOccupancyMaxActiveBlocksPerMultiprocessor(&per_cu, (const void*)fwd_kernel, 512, LDS_BYTES);
        if (per_cu < 1) per_cu = 1;
        grid_blocks = cus * per_cu;
    }
    if (grid_blocks < 0) return;
    Params P{};
    const float** pp = (const float**)&P;
    for (int i = 0; i < 25; ++i) pp[i] = (const float*)d_in[i];
    P.out = (float*)d_out; P.ws = (unsigned char*)d_ws;
    if (hipMemsetAsync((char*)d_ws + OFF_BAR, 0, 16384, stream) != hipSuccess) { fprintf(stderr, "kernel_launch: memset of barrier words failed\n"); return; }
    void* args[] = {&P};
    hipError_t e = hipLaunchCooperativeKernel((const void*)fwd_kernel, dim3(grid_blocks), dim3(512), args, LDS_BYTES, stream);
    if (e != hipSuccess) fprintf(stderr, "cooperative launch failed: %s (grid %d)\n", hipGetErrorString(e), grid_blocks);
}
```

```cpp
#include <hip/hip_runtime.h>
#include <hip/hip_cooperative_groups.h>
#include <cstdio>
namespace cg = cooperative_groups;

#define LAS __attribute__((address_space(3)))
typedef unsigned short bf16_t;
typedef short bf16x8 __attribute__((ext_vector_type(8)));
typedef float f32x4 __attribute__((ext_vector_type(4)));
typedef unsigned u32x4 __attribute__((ext_vector_type(4)));
typedef unsigned u32x2 __attribute__((ext_vector_type(2)));

constexpr int D = 1024, NLAT = 32768, NROW = 33792, DFF = 4096;
constexpr int CRR = 1056, CR_PAD = 1280, XS_K = 768;
constexpr int LDS_BYTES = 147456;

constexpr size_t OFF_W1 = 0;
constexpr size_t OFF_W2 = OFF_W1 + 33554432;
constexpr size_t OFF_WG = OFF_W2 + 33554432;
constexpr size_t OFF_WP = OFF_WG + 4194304;
constexpr size_t OFF_MOD = OFF_WP + 1048576;
constexpr size_t OFF_XC = OFF_MOD + 491520;
constexpr size_t OFF_XN = OFF_XC + 4194304;
constexpr size_t OFF_Z = OFF_XN + 69206016;
constexpr size_t OFF_ACT = OFF_Z + 69206016;
constexpr size_t OFF_MTAB = OFF_ACT + 276824064;
constexpr size_t OFF_BAR = OFF_MTAB + 8388608;
constexpr size_t WS_END = OFF_BAR + 16384;
constexpr size_t OFF_TC = OFF_ACT;
constexpr size_t OFF_SM = OFF_TC + 50331648;
constexpr size_t OFF_SL = OFF_SM + 16777216;
constexpr size_t OFF_XS = OFF_SL + 83886080;

struct Params {
    const float *x, *c, *ctx, *c_ctx, *ada_w, *ada_b, *norm1_g, *norm2_g, *a_re, *a_im, *log_dt, *b_re, *b_im, *c_re, *c_im, *s5_d, *glu_w, *glu_b,
        *pool_w, *pool_scale, *w1, *b1, *w2, *b2, *final_g;
    float* out;
    unsigned char* ws;
};

__device__ __forceinline__ unsigned pk2(float lo, float hi) { unsigned r; asm("v_cvt_pk_bf16_f32 %0, %1, %2" : "=v"(r) : "v"(lo), "v"(hi)); return r; }
__device__ __forceinline__ float bflo(unsigned w) { return __uint_as_float(w << 16); }
__device__ __forceinline__ float bfhi(unsigned w) { return __uint_as_float(w & 0xffff0000u); }
__device__ __forceinline__ float wave_sum(float v) {
#pragma unroll
    for (int o = 1; o < 64; o <<= 1) v += __shfl_xor(v, o);
    return v;
}
__device__ __forceinline__ float fast_exp(float x) { return __builtin_amdgcn_exp2f(x * 1.4426950408889634f); }
__device__ __forceinline__ float fast_sigmoid(float x) { return __builtin_amdgcn_rcpf(1.0f + fast_exp(-x)); }
__device__ __forceinline__ float gelu_tanh(float v) {
    const float inner = 1.5957691216057308f * (v + 0.044715f * v * v * v);
    return v * fast_sigmoid(inner);
}
__device__ __forceinline__ void cpowk(float dar, float dai, int k, float& re, float& im) {
    const float mag = fast_exp((float)k * dar);
    double rv = (double)k * (double)dai * 0.15915494309189535; rv -= __builtin_rint(rv);
    const float fr = (float)rv;
    re = mag * __builtin_amdgcn_cosf(fr); im = mag * __builtin_amdgcn_sinf(fr);
}


#define XB_TMO      128
#define XB_XCNT(j)  (256  + 64 * (j))
#define XB_XSUB(j)  (1280 + 64 * (j))
#define XB_XGEN(j)  (2304 + 64 * (j))
#define XB_TOP      3328
#define XB_TOPGEN   3392
#define XCD_BAR_WORDS 3456
#define XB_SPIN_CAP (1u << 22)
__device__ __forceinline__ unsigned xb_ld(unsigned* p)              { return __hip_atomic_load(p, __ATOMIC_RELAXED, __HIP_MEMORY_SCOPE_AGENT); }
__device__ __forceinline__ unsigned xb_add(unsigned* p, unsigned v) { return __hip_atomic_fetch_add(p, v, __ATOMIC_RELAXED, __HIP_MEMORY_SCOPE_AGENT); }
__device__ __forceinline__ unsigned xb_xcc_id() { return (unsigned)__builtin_amdgcn_s_getreg((3 << 11) | 20) & 0xFu; }
#define XB_SPIN(cond, bar) do { unsigned _sp = 0; while (cond) { __builtin_amdgcn_s_sleep(1); \
    if ((++_sp & 255u) == 0u) { if (xb_ld(&(bar)[XB_TMO])) break; if (_sp > XB_SPIN_CAP) { atomicAdd(&(bar)[XB_TMO], 1u); break; } } } } while (0)
struct XcdBarrier { unsigned* bar; unsigned x; volatile LAS unsigned* st; };
__device__ __forceinline__ XcdBarrier xcd_barrier_post(unsigned* bar, volatile LAS unsigned* st) {
    XcdBarrier b; b.bar = bar; b.x = xb_xcc_id(); b.st = st;
    if (threadIdx.x == 0) (void)xb_add(&bar[XB_XCNT(b.x)], 1u);
    return b;
}
__device__ __forceinline__ void xcd_barrier_complete(unsigned* bar, unsigned x, unsigned& nloc, unsigned& nx) {
    const unsigned G = gridDim.x * gridDim.y * gridDim.z;
    unsigned sum, cnt, mine, sp = 0u;
    for (;;) {
        sum = 0u; cnt = 0u; mine = 0u;
#pragma unroll
        for (unsigned j = 0; j < 16; ++j) { const unsigned c = xb_ld(&bar[XB_XCNT(j)]); sum += c; cnt += (c > 0u) ? 1u : 0u; mine = (j == x) ? c : mine; }
        if (sum == G) break;
        __builtin_amdgcn_s_sleep(1);
        if ((++sp & 255u) == 0u) { if (xb_ld(&bar[XB_TMO])) break; if (sp > XB_SPIN_CAP) { atomicAdd(&bar[XB_TMO], 1u); break; } }
    }
    nloc = mine > 0u ? mine : 1u; nx = cnt > 0u ? cnt : 1u;
}
__device__ __forceinline__ void xcd_barrier(const XcdBarrier& b) {
    asm volatile("s_waitcnt vmcnt(0)" ::: "memory");
    __syncthreads();
    if (threadIdx.x == 0) {
        unsigned* bar = b.bar;
        __builtin_amdgcn_s_waitcnt(0);
        unsigned nloc = b.st[0], nx = b.st[1];
        if (nloc == 0u) { xcd_barrier_complete(bar, b.x, nloc, nx); b.st[0] = nloc; b.st[1] = nx; }
        const unsigned old = xb_add(&bar[XB_XSUB(b.x)], 1u);
        const unsigned gen = old / nloc;
        if (old + 1u == (gen + 1u) * nloc) {
            __builtin_amdgcn_fence(__ATOMIC_RELEASE, "agent");
            asm volatile("s_waitcnt vmcnt(0)" ::: "memory");
            const unsigned og = xb_add(&bar[XB_TOP], 1u);
            const unsigned tg = og / nx;
            if (og + 1u == (tg + 1u) * nx) xb_add(&bar[XB_TOPGEN], 1u);
            else XB_SPIN(xb_ld(&bar[XB_TOPGEN]) == tg, bar);
            __builtin_amdgcn_fence(__ATOMIC_ACQUIRE, "agent");
            xb_add(&bar[XB_XGEN(b.x)], 1u);
            asm volatile("s_waitcnt vmcnt(0)" ::: "memory");
        } else {
            XB_SPIN(xb_ld(&bar[XB_XGEN(b.x)]) == gen, bar);
            __builtin_amdgcn_fence(__ATOMIC_ACQUIRE, "agent");
            asm volatile("s_waitcnt vmcnt(0)" ::: "memory");
        }
    }
    __syncthreads();
}

namespace pg8 {
constexpr int BM = 256, BK = 64, HALF = 128, HTB = HALF * BK * 2, NXCD = 8, WGM = 8;
__device__ __forceinline__ int lds_byte(int r, int c) { const int st = (r >> 4) * 2 + (c >> 5), rr = r & 15, cc = c & 31, ob = rr * 64 + cc * 2; return st * 1024 + (ob ^ (((ob >> 9) & 1) << 5)); }
__device__ __forceinline__ void stage_rc(int b, int& R, int& C) { const int st = b / 1024, sb = b % 1024, swz = sb ^ (((sb >> 9) & 1) << 5); R = (st >> 1) * 16 + swz / 64; C = (st & 1) * 32 + (swz % 64) / 2; }
__device__ __forceinline__ int perm32(int rho) { const int n = rho >> 4, i = rho & 15; return 8 * (i >> 2) + 4 * n + (i & 3); }

struct Unit { int pm, pn, grp; };
struct Gemm { const bf16_t* A; const bf16_t* Bt; int lda, K; long a_gs, b_gs; int a_gm; };

struct Sched {
    int nM, nN, nwg, nG, G, c, gx;
    __device__ __forceinline__ void init(int nM_, int nN_, int nG_, int G_, int c_, int gx_ = 0) { nM = nM_; nN = nN_; nwg = nM_ * nN_; nG = nG_; G = G_; c = c_; gx = gx_; }
    __device__ __forceinline__ bool next(int i, Unit& u) const {
        const long L = (long)i * G + c; if (L >= (long)nwg * nG) return false;
        if (gx && G == 256 && (nwg == 4 || nwg == 8)) {
            const int x = c & 7, q = c >> 3, gpx = 32 / nwg;
            u.grp = i * (8 * gpx) + x * gpx + q / nwg; const int w = q % nwg; u.pm = w / nN; u.pn = w % nN; return true; }
        u.grp = (int)(L / nwg); int wgid = (int)(L % nwg);
        { const int q = nwg / NXCD, r = nwg % NXCD, xcd = wgid % NXCD, off = wgid / NXCD; wgid = (xcd < r ? xcd * (q + 1) : r * (q + 1) + (xcd - r) * q) + off; }
        const int nig = WGM * nN, gid = wgid / nig, fm = gid * WGM, gsz = (nM - fm) < WGM ? (nM - fm) : WGM;
        u.pm = fm + ((wgid % nig) % gsz); u.pn = (wgid % nig) / gsz; return true;
    }
};

__device__ __forceinline__ void zero4(f32x4& v) { float a, b, c, d; asm volatile("v_mov_b32 %0, 0\n\tv_mov_b32 %1, 0\n\tv_mov_b32 %2, 0\n\tv_mov_b32 %3, 0" : "=v"(a), "=v"(b), "=v"(c), "=v"(d)); v = (f32x4){a, b, c, d}; }
template <class Epi>
__device__ __forceinline__ void gemm_phase(LAS unsigned char* lds, const Gemm g, const Sched& S, const Epi& E) {
    int tid = threadIdx.x; asm volatile("" : "+v"(tid));
    const int wid = __builtin_amdgcn_readfirstlane(tid >> 6), lane = tid & 63, wr = wid >> 2, wc = wid & 3, fr = lane & 15, fq = lane >> 4;
    int K = g.K, lda = g.lda; asm volatile("" : "+s"(K), "+s"(lda));
    const int nt = K / BK;
    unsigned voffA[2], voffB[2];
#pragma unroll
    for (int i = 0; i < 2; ++i) { int R, C; stage_rc(tid * 16 + i * 8192, R, C); const int Rb = Epi::PERM ? ((R & ~31) + perm32(R & 31)) : R;
        voffA[i] = g.a_gm ? (unsigned)(((C >> 4) * g.a_gm + R) * 16 + (C & 15)) * 2u : (unsigned)(R * lda + C) * 2u; voffB[i] = (unsigned)(Rb * K + C) * 2u; }
    const size_t kstep = (size_t)(BK * 2);
    const size_t kstepA = g.a_gm ? (size_t)g.a_gm * 128 : kstep;
    const size_t hstepA = g.a_gm ? (size_t)HALF * 32 : (size_t)HALF * lda * 2, hstepB = (size_t)HALF * K * 2;
    const size_t tstepA = 2 * hstepA, tstepB = 2 * hstepB;
    const unsigned ldsw = (unsigned)wid * 1024u;
    const int aoff = lds_byte(wr * 64 + fr, fq * 8), boff = lds_byte(wc * 32 + fr, fq * 8);
#define PG8_SA(b, h) (((b) * 2 + (h)) * HTB)
#define PG8_SB(b, h) ((4 + (b) * 2 + (h)) * HTB)
#define PG8_STAGE(bufoff, gbase, voff) do { _Pragma("unroll") for (int _i = 0; _i < 2; ++_i) \
        __builtin_amdgcn_global_load_lds((const unsigned*)((const char*)(gbase) + (voff)[_i]), (LAS unsigned*)(lds + (bufoff) + ldsw + _i * 8192), 16, 0, 0); } while (0)
#define PG8_LDA(dst, b, h) do { _Pragma("unroll") for (int m = 0; m < 4; ++m) _Pragma("unroll") for (int k = 0; k < 2; ++k) dst[m][k] = *(const LAS bf16x8*)(lds + PG8_SA(b, h) + aoff + m * 2048 + k * 1024); } while (0)
#define PG8_LDB(dst, b, h) do { _Pragma("unroll") for (int n = 0; n < 2; ++n) _Pragma("unroll") for (int k = 0; k < 2; ++k) dst[n][k] = *(const LAS bf16x8*)(lds + PG8_SB(b, h) + boff + n * 2048 + k * 1024); } while (0)
#define PG8_MMA(ai, bj, At, Bt) do { __builtin_amdgcn_s_setprio(1); _Pragma("unroll") for (int m = 0; m < 4; ++m) _Pragma("unroll") for (int n = 0; n < 2; ++n) _Pragma("unroll") for (int k = 0; k < 2; ++k) \
        acc[ai][bj][m][n] = __builtin_amdgcn_mfma_f32_16x16x32_bf16(Bt[n][k], At[m][k], acc[ai][bj][m][n], 0, 0, 0); __builtin_amdgcn_s_setprio(0); } while (0)
#define PG8_WAIT_V(n) asm volatile("s_waitcnt vmcnt(" #n ")" ::: "memory")
#define PG8_WAIT_L(n) asm volatile("s_waitcnt lgkmcnt(" #n ")" ::: "memory")
#define PG8_BAR __builtin_amdgcn_s_barrier()
#define PG8_SCHED __builtin_amdgcn_sched_barrier(0)
    Unit cur, nxt; int ui = 0;
    if (!S.next(0, cur)) return;
    f32x4 acc[2][2][4][2];
#pragma unroll
    for (int a = 0; a < 2; ++a)
#pragma unroll
        for (int b = 0; b < 2; ++b)
#pragma unroll
            for (int m = 0; m < 4; ++m)
#pragma unroll
                for (int n = 0; n < 2; ++n) zero4(acc[a][b][m][n]);
    bf16x8 At[4][2], B0[2][2], B1[2][2];
    const char* cA = (const char*)(g.A + (size_t)cur.grp * g.a_gs) + (size_t)cur.pm * tstepA;
    const char* cB = (const char*)(g.Bt + (size_t)cur.grp * g.b_gs) + (size_t)cur.pn * tstepB;
    PG8_STAGE(PG8_SB(0, 0), cB, voffB); PG8_STAGE(PG8_SA(0, 0), cA, voffA); PG8_STAGE(PG8_SB(0, 1), cB + hstepB, voffB); PG8_STAGE(PG8_SA(0, 1), cA + hstepA, voffA);
    if (wr == 1) PG8_BAR;
    PG8_WAIT_V(4); PG8_BAR;
    PG8_STAGE(PG8_SB(1, 0), cB + kstep, voffB); PG8_STAGE(PG8_SA(1, 0), cA + kstepA, voffA); PG8_STAGE(PG8_SB(1, 1), cB + hstepB + kstep, voffB);
    PG8_WAIT_V(6); PG8_BAR;
    for (;;) {
        const bool has_next = S.next(ui + 1, nxt);
        const char* nA = has_next ? (const char*)(g.A + (size_t)nxt.grp * g.a_gs) + (size_t)nxt.pm * tstepA : cA;
        const char* nB = has_next ? (const char*)(g.Bt + (size_t)nxt.grp * g.b_gs) + (size_t)nxt.pn * tstepB : cB;
        for (int t = 0; t < nt; t += 2) {
            const bool last = (t == nt - 2);
            const char* a1 = cA + (size_t)(t + 1) * kstepA;
            const char* a2 = last ? nA : cA + (size_t)(t + 2) * kstepA; const char* b2 = last ? nB : cB + (size_t)(t + 2) * kstep;
            const char* sA11 = a1 + hstepA; const char* sB00 = b2; const char* sA00 = a2; const char* sB01 = b2 + hstepB; const char* sA01 = a2 + hstepA;
            const char* sB10 = b2 + kstep; const char* sA10 = a2 + kstepA; const char* sB11 = b2 + kstep + hstepB;
            asm volatile("" : "+s"(sA11), "+s"(sB00), "+s"(sA00), "+s"(sB01)); asm volatile("" : "+s"(sA01), "+s"(sB10), "+s"(sA10), "+s"(sB11));
            PG8_LDB(B0, 0, 0); PG8_SCHED; PG8_LDA(At, 0, 0); PG8_STAGE(PG8_SA(1, 1), sA11, voffA);
            PG8_WAIT_L(8); PG8_BAR; PG8_WAIT_L(0); PG8_MMA(0, 0, At, B0); PG8_BAR; PG8_SCHED;
            PG8_LDB(B1, 0, 1); PG8_STAGE(PG8_SB(0, 0), sB00, voffB);
            PG8_BAR; PG8_WAIT_L(0); PG8_MMA(0, 1, At, B1); PG8_BAR;
            PG8_LDA(At, 0, 1); PG8_STAGE(PG8_SA(0, 0), sA00, voffA);
            PG8_BAR; PG8_WAIT_L(0); PG8_MMA(1, 0, At, B0); PG8_BAR; PG8_SCHED;
            PG8_STAGE(PG8_SB(0, 1), sB01, voffB);
            PG8_WAIT_V(6); PG8_BAR; PG8_MMA(1, 1, At, B1); PG8_BAR;
            PG8_LDB(B0, 1, 0); PG8_SCHED; PG8_LDA(At, 1, 0); PG8_STAGE(PG8_SA(0, 1), sA01, voffA);
            PG8_WAIT_L(8); PG8_BAR; PG8_WAIT_L(0); PG8_MMA(0, 0, At, B0); PG8_BAR; PG8_SCHED;
            PG8_LDB(B1, 1, 1); PG8_STAGE(PG8_SB(1, 0), sB10, voffB);
            PG8_BAR; PG8_WAIT_L(0); PG8_MMA(0, 1, At, B1); PG8_BAR;
            PG8_LDA(At, 1, 1); PG8_STAGE(PG8_SA(1, 0), sA10, voffA);
            PG8_BAR; PG8_WAIT_L(0); PG8_MMA(1, 0, At, B0); PG8_BAR; PG8_SCHED;
            PG8_STAGE(PG8_SB(1, 1), sB11, voffB);
            PG8_WAIT_V(6); PG8_BAR; PG8_MMA(1, 1, At, B1); PG8_BAR;
        }
        E(acc, cur, wr, wc, fr, fq);
        if (!has_next) break;
#pragma unroll
        for (int a = 0; a < 2; ++a)
#pragma unroll
            for (int b = 0; b < 2; ++b)
#pragma unroll
                for (int m = 0; m < 4; ++m)
#pragma unroll
                    for (int n = 0; n < 2; ++n) zero4(acc[a][b][m][n]);
        cur = nxt; cA = nA; cB = nB; ++ui;
    }
    PG8_WAIT_V(0);
    if (wr == 0) PG8_BAR;
    PG8_BAR;
#undef PG8_SA
#undef PG8_SB
#undef PG8_STAGE
#undef PG8_LDA
#undef PG8_LDB
#undef PG8_MMA
#undef PG8_WAIT_V
#undef PG8_WAIT_L
#undef PG8_BAR
#undef PG8_SCHED
}
}
using pg8::Unit;

struct XPtr { float* out; float* xc;
    __device__ __forceinline__ float* tile(int pm) const { return pm < 128 ? out + (size_t)pm * 256 * D : xc + (size_t)(pm - 128) * 256 * D; } };


#define RMW_ROWOFF(g) ((size_t)((((g) >> 2) * 128) + (((g) & 3) * 16)))
template <bool ZAUX, int CH, class F>
__device__ __forceinline__ void rmw_pipeline(float* xb, const float* xs, const bf16_t* zb, F&& f) {
    constexpr int SPG = 4 / CH, NST = 8 * SPG;
    f32x4 xv[2][CH]; u32x2 zz[2][CH];
#define RMW_ISSUE(st, s_) do { const int g_ = (st) / SPG, c0_ = ((st) % SPG) * CH; const float* rp = xs + RMW_ROWOFF(g_) * D; \
        _Pragma("unroll") for (int c = 0; c < CH; ++c) { const int cc = c0_ + c; xv[s_][c] = *(const f32x4*)(rp + (cc >> 1) * 128 + (cc & 1) * 16); \
            if (ZAUX) zz[s_][c] = *(const u32x2*)(zb + RMW_ROWOFF(g_) * 16 + (size_t)((cc >> 1) * 8 + (cc & 1)) * NROW * 16); } } while (0)
    RMW_ISSUE(0, 0); RMW_ISSUE(1, 1);
    __builtin_amdgcn_sched_barrier(0);
#pragma unroll
    for (int st = 0; st < NST; ++st) { const int s_ = st % 2, g = st / SPG, c0 = (st % SPG) * CH; float* wp = xb + RMW_ROWOFF(g) * D;
#pragma unroll
        for (int c = 0; c < CH; ++c) { const int cc = c0 + c; *(f32x4*)(wp + (cc >> 1) * 128 + (cc & 1) * 16) = f(g, cc, xv[s_][c], zz[s_][c]); }
        if (st + 2 < NST) RMW_ISSUE(st + 2, s_);
        __builtin_amdgcn_sched_barrier(0); }
#undef RMW_ISSUE
}

struct EpiM1 {
    static constexpr bool PERM = true;
    bf16_t* O; const float* bias;
    __device__ __forceinline__ void operator()(const f32x4 (&acc)[2][2][4][2], const Unit& u, int wr, int wc, int fr, int fq) const {
        const int row0 = u.pm * 256 + wr * 64 + fr, col0 = u.pn * 256 + wc * 32 + 8 * fq;
        f32x4 bv[2][2];
#pragma unroll
        for (int bj = 0; bj < 2; ++bj)
#pragma unroll
            for (int n = 0; n < 2; ++n) bv[bj][n] = *(const f32x4*)(bias + col0 + bj * 128 + 4 * n);
#pragma unroll
        for (int ai = 0; ai < 2; ++ai)
#pragma unroll
            for (int m = 0; m < 4; ++m) { bf16_t* rowp = O + (size_t)(row0 + ai * 128 + m * 16) * DFF + col0;
#pragma unroll
                for (int bj = 0; bj < 2; ++bj) { f32x4 v0 = acc[ai][bj][m][0] + bv[bj][0], v1 = acc[ai][bj][m][1] + bv[bj][1];
#pragma unroll
                    for (int j = 0; j < 4; ++j) { const float a0 = fmaxf(v0[j], 0.f), a1 = fmaxf(v1[j], 0.f); v0[j] = a0 * a0; v1[j] = a1 * a1; }
                    u32x4 w; w.x = pk2(v0[0], v0[1]); w.y = pk2(v0[2], v0[3]); w.z = pk2(v1[0], v1[1]); w.w = pk2(v1[2], v1[3]);
                    *(u32x4*)(rowp + bj * 128) = w; } }
    }
};
struct EpiM2 {
    static constexpr bool PERM = false;
    XPtr X; const float* bias; const float* modl; float gsc;
    __device__ __forceinline__ void operator()(const f32x4 (&acc)[2][2][4][2], const Unit& u, int wr, int wc, int fr, int fq) const {
        const int col0 = u.pn * 256 + wc * 32 + 4 * fq; const int bi = u.pm < 128 ? (u.pm >> 5) : 4;
        const float* gate = modl + bi * 6144 + 5120;
        float* xb = X.tile(u.pm) + (size_t)(wr * 64 + fr) * D + col0;
        f32x4 bv[2][2], gv[2][2];
#pragma unroll
        for (int bj = 0; bj < 2; ++bj)
#pragma unroll
            for (int n = 0; n < 2; ++n) { bv[bj][n] = *(const f32x4*)(bias + col0 + bj * 128 + n * 16); gv[bj][n] = *(const f32x4*)(gate + col0 + bj * 128 + n * 16) * gsc; }
        rmw_pipeline<false, 4>(xb, xb, nullptr, [&](int g, int c, f32x4 xv, u32x2) { return xv + gv[c >> 1][c & 1] * (acc[g >> 2][c >> 1][g & 3][c & 1] + bv[c >> 1][c & 1]); });
    }
};
struct EpiGLU {
    static constexpr bool PERM = false;
    XPtr X; const bf16_t* Z; const float* bias; const float* modl; float gsc; const float* xsrc;
    __device__ __forceinline__ void operator()(const f32x4 (&acc)[2][2][4][2], const Unit& u, int wr, int wc, int fr, int fq) const {
        const int col0 = u.pn * 256 + wc * 32 + 4 * fq; const int bi = u.pm < 128 ? (u.pm >> 5) : 4;
        const float* gate = modl + bi * 6144 + 2048;
        float* xb = X.tile(u.pm) + (size_t)(wr * 64 + fr) * D + col0;
        const float* xs = xsrc + ((size_t)u.pm * 256 + wr * 64 + fr) * D + col0;
        const bf16_t* zb = Z + ((size_t)(col0 >> 4) * NROW + u.pm * 256 + wr * 64 + fr) * 16 + (col0 & 15);
        f32x4 bv[2][2], gv[2][2];
#pragma unroll
        for (int bj = 0; bj < 2; ++bj)
#pragma unroll
            for (int n = 0; n < 2; ++n) { bv[bj][n] = *(const f32x4*)(bias + col0 + bj * 128 + n * 16); gv[bj][n] = *(const f32x4*)(gate + col0 + bj * 128 + n * 16) * gsc; }
        rmw_pipeline<true, 2>(xb, xs, zb, [&](int g, int c, f32x4 xv, u32x2 zz) { const f32x4 a = acc[g >> 2][c >> 1][g & 3][c & 1] + bv[c >> 1][c & 1]; f32x4 y;
            y[0] = bflo(zz.x) * fast_sigmoid(a[0]); y[1] = bfhi(zz.x) * fast_sigmoid(a[1]); y[2] = bflo(zz.y) * fast_sigmoid(a[2]); y[3] = bfhi(zz.y) * fast_sigmoid(a[3]);
            return xv + gv[c >> 1][c & 1] * y; });
    }
};
struct EpiPool {
    static constexpr bool PERM = false;
    XPtr X; const float* pscale; const float* modl; float gsc;
    __device__ __forceinline__ void operator()(const f32x4 (&acc)[2][2][4][2], const Unit& u, int wr, int wc, int fr, int fq) const {
        const int col0 = u.grp * 256 + wc * 32 + 4 * fq; const int bi = u.pm < 128 ? (u.pm >> 5) : 4;
        const float* gate = modl + bi * 6144 + 2048;
        float* xb = X.tile(u.pm) + (size_t)(wr * 64 + fr) * D + col0;
        f32x4 gv[2][2];
#pragma unroll
        for (int bj = 0; bj < 2; ++bj)
#pragma unroll
            for (int n = 0; n < 2; ++n) gv[bj][n] = *(const f32x4*)(gate + col0 + bj * 128 + n * 16) * *(const f32x4*)(pscale + col0 + bj * 128 + n * 16) * gsc;
        rmw_pipeline<false, 4>(xb, xb, nullptr, [&](int g, int c, f32x4 xv, u32x2) { return xv + gv[c >> 1][c & 1] * acc[g >> 2][c >> 1][g & 3][c & 1]; });
    }
};
struct EpiG1 {
    static constexpr bool PERM = false;
    float* SL;
    __device__ __forceinline__ void operator()(const f32x4 (&acc)[2][2][4][2], const Unit& u, int wr, int wc, int fr, int fq) const {
        float* b = SL + ((size_t)u.grp * CR_PAD + u.pm * 256 + wr * 64 + fr) * 256 + wc * 32 + 4 * fq;
#pragma unroll
        for (int ai = 0; ai < 2; ++ai)
#pragma unroll
            for (int m = 0; m < 4; ++m) { float* rowp = b + (size_t)(ai * 128 + m * 16) * 256;
#pragma unroll
                for (int bj = 0; bj < 2; ++bj)
#pragma unroll
                    for (int n = 0; n < 2; ++n) *(f32x4*)(rowp + bj * 128 + n * 16) = acc[ai][bj][m][n]; }
    }
};
struct EpiG2 {
    static constexpr bool PERM = true;
    bf16_t* Z; const bf16_t* XS; const float* dsk;
    __device__ __forceinline__ void operator()(const f32x4 (&acc)[2][2][4][2], const Unit& u, int wr, int wc, int fr, int fq) const {
        const int g = u.grp, ho0 = 8 * (fq & 1), ch = 16 * g + ho0;
#pragma unroll
        for (int ai = 0; ai < 2; ++ai)
#pragma unroll
            for (int m = 0; m < 4; ++m) { const int cr = u.pm * 256 + ai * 128 + wr * 64 + m * 16 + fr;
                if (cr < CRR) {
                    const int trow0 = cr < 1024 ? (cr >> 8) * 8192 + (cr & 255) * 32 : NLAT + (cr - 1024) * 32;
#pragma unroll
                    for (int bj = 0; bj < 2; ++bj) { const int t = 16 * u.pn + 8 * bj + 2 * wc + (fq >> 1);
                        f32x4 v0 = acc[ai][bj][m][0], v1 = acc[ai][bj][m][1];
#pragma unroll
                        for (int j = 0; j < 4; ++j) { v0[j] = gelu_tanh(v0[j]); v1[j] = gelu_tanh(v1[j]); }
                        u32x4 w; w.x = pk2(v0[0], v0[1]); w.y = pk2(v0[2], v0[3]); w.z = pk2(v1[0], v1[1]); w.w = pk2(v1[2], v1[3]);
                        *(u32x4*)(Z + ((size_t)g * NROW + trow0 + t) * 16 + ho0) = w; } } }
    }
};

__device__ __forceinline__ void transpose_item(const float* W, int K, int N, bf16_t* WT, LAS float* scr, int item, int lane) {
    const int nblk = N / 32, kb = item / nblk, nbk = item % nblk, k0 = 64 * kb, n0 = 32 * nbk;
#pragma unroll
    for (int i = 0; i < 32; ++i) { const int kk = 2 * i + (lane >> 5); scr[kk * 33 + (lane & 31)] = W[(size_t)(k0 + kk) * N + n0 + (lane & 31)]; }
    asm volatile("s_waitcnt lgkmcnt(0)" ::: "memory");
    const int c = lane & 7;
#pragma unroll
    for (int j = 0; j < 4; ++j) { const int n = (lane >> 3) + 8 * j; const LAS float* s = scr + (8 * c) * 33 + n;
        u32x4 o; o.x = pk2(s[0 * 33], s[1 * 33]); o.y = pk2(s[2 * 33], s[3 * 33]); o.z = pk2(s[4 * 33], s[5 * 33]); o.w = pk2(s[6 * 33], s[7 * 33]);
        *(u32x4*)(WT + (size_t)(n0 + n) * K + k0 + 8 * c) = o; }
    asm volatile("s_waitcnt lgkmcnt(0)" ::: "memory");
}

__device__ __forceinline__ void s5_disc(const Params& P, int j, int dir, int g, int p, float& dar, float& dai, float& kr, float& ki) {
    const int gi = (j * 2 + dir) * 64 + g, idx = gi * 64 + p;
    const float are = P.a_re[idx], aim = P.a_im[idx], dt = expf(P.log_dt[gi]);
    dar = are * dt; dai = aim * dt;
    float lr, li; cpowk(dar, dai, 1, lr, li);
    const float den = are * are + aim * aim, nr = lr - 1.0f, ni = li;
    kr = (nr * are + ni * aim) / den; ki = (ni * are - nr * aim) / den;
}

__device__ __forceinline__ void norm_row_tm(const float* xr, const float* gam, const float* sh, const float* sc, bf16_t* orow, int lane) {
    f32x4 v[4]; float ss = 0.f;
#pragma unroll
    for (int j = 0; j < 4; ++j) { v[j] = ((const f32x4*)xr)[lane + 64 * j]; ss += (v[j][0] * v[j][0] + v[j][1] * v[j][1]) + (v[j][2] * v[j][2] + v[j][3] * v[j][3]); }
    const float rstd = rsqrtf(wave_sum(ss) * (1.0f / D) + 1e-6f);
#pragma unroll
    for (int j = 0; j < 4; ++j) { const int cidx = lane + 64 * j;
        const f32x4 gg = ((const f32x4*)gam)[cidx], s1 = ((const f32x4*)sc)[cidx], s0 = ((const f32x4*)sh)[cidx];
        const f32x4 o = v[j] * rstd * gg * (s1 + 1.0f) + s0;
        u32x2 w; w.x = pk2(o[0], o[1]); w.y = pk2(o[2], o[3]);
        ((u32x2*)orow)[cidx] = w; }
}


__device__ __forceinline__ void norm_rows2_tm(const float* x0, const float* x1, const float* gam, const float* md0, const float* md1, bf16_t* o0, bf16_t* o1, int lane) {
    f32x4 v0[4], v1[4], gg[4], c0[4], h0[4], c1[4], h1[4];
#pragma unroll
    for (int j = 0; j < 4; ++j) { const int cidx = lane + 64 * j; v0[j] = ((const f32x4*)x0)[cidx]; v1[j] = ((const f32x4*)x1)[cidx]; }
#pragma unroll
    for (int j = 0; j < 4; ++j) { const int cidx = lane + 64 * j; gg[j] = ((const f32x4*)gam)[cidx];
        c0[j] = ((const f32x4*)(md0 + 1024))[cidx]; h0[j] = ((const f32x4*)md0)[cidx]; c1[j] = ((const f32x4*)(md1 + 1024))[cidx]; h1[j] = ((const f32x4*)md1)[cidx]; }
    __builtin_amdgcn_sched_barrier(0);
    float s0 = 0.f, s1 = 0.f;
#pragma unroll
    for (int j = 0; j < 4; ++j) { s0 += (v0[j][0] * v0[j][0] + v0[j][1] * v0[j][1]) + (v0[j][2] * v0[j][2] + v0[j][3] * v0[j][3]);
        s1 += (v1[j][0] * v1[j][0] + v1[j][1] * v1[j][1]) + (v1[j][2] * v1[j][2] + v1[j][3] * v1[j][3]); }
    const float r0 = rsqrtf(wave_sum(s0) * (1.0f / D) + 1e-6f), r1 = rsqrtf(wave_sum(s1) * (1.0f / D) + 1e-6f);
#pragma unroll
    for (int j = 0; j < 4; ++j) { const int cidx = lane + 64 * j;
        const f32x4 a0 = v0[j] * r0 * gg[j] * (c0[j] + 1.0f) + h0[j];
        const f32x4 a1 = v1[j] * r1 * gg[j] * (c1[j] + 1.0f) + h1[j];
        u32x2 w; w.x = pk2(a0[0], a0[1]); w.y = pk2(a0[2], a0[3]); ((u32x2*)o0)[cidx] = w;
        w.x = pk2(a1[0], a1[1]); w.y = pk2(a1[2], a1[3]); ((u32x2*)o1)[cidx] = w; }
}


template <int MT, int K>
__device__ __forceinline__ void ctx_tile(LAS float* part, const bf16_t* A, int lda, const bf16_t* Bt, int ldb, int tid, int a_gm = 0) {
    const int wave = tid >> 6, lane = tid & 63, fr = lane & 15, fq = lane >> 4;
    constexpr int MI = MT / 16;
    f32x4 acc[MI][4];
#pragma unroll
    for (int mi = 0; mi < MI; ++mi)
#pragma unroll
        for (int ni = 0; ni < 4; ++ni) acc[mi][ni] = (f32x4){0.f, 0.f, 0.f, 0.f};
    constexpr int kw = K >> 3;
    const bf16_t* a0 = A + (size_t)fr * lda + wave * kw + fq * 8;
    const bf16_t* b0 = Bt + (size_t)fr * ldb + wave * kw + fq * 8;
    bf16x8 af[2][MI], bfr[2][4];
#define CT_LOAD(buf, k) do { _Pragma("unroll") for (int mi = 0; mi < MI; ++mi) { const int kk = wave * kw + (k) + fq * 8; \
            af[buf][mi] = a_gm ? *(const bf16x8*)(A + ((size_t)(kk >> 4) * a_gm + mi * 16 + fr) * 16 + (kk & 15)) : *(const bf16x8*)(a0 + (size_t)mi * 16 * lda + (k)); } \
        _Pragma("unroll") for (int ni = 0; ni < 4; ++ni) bfr[buf][ni] = *(const bf16x8*)(b0 + (size_t)ni * 16 * ldb + (k)); } while (0)
#define CT_MMA(buf) do { _Pragma("unroll") for (int mi = 0; mi < MI; ++mi) _Pragma("unroll") for (int ni = 0; ni < 4; ++ni) \
            acc[mi][ni] = __builtin_amdgcn_mfma_f32_16x16x32_bf16(bfr[buf][ni], af[buf][mi], acc[mi][ni], 0, 0, 0); } while (0)
    CT_LOAD(0, 0);
#pragma unroll
    for (int k = 0; k < kw; k += 64) {
        if (k + 32 < kw) CT_LOAD(1, k + 32);
        __builtin_amdgcn_sched_barrier(0);
        CT_MMA(0);
        __builtin_amdgcn_sched_barrier(0);
        if (k + 64 < kw) CT_LOAD(0, k + 64);
        __builtin_amdgcn_sched_barrier(0);
        if (k + 32 < kw) CT_MMA(1);
        __builtin_amdgcn_sched_barrier(0);
    }
#undef CT_LOAD
#undef CT_MMA
    LAS float* pw = part + wave * (MT * 68);
#pragma unroll
    for (int mi = 0; mi < MI; ++mi)
#pragma unroll
        for (int ni = 0; ni < 4; ++ni) *(LAS f32x4*)(pw + (mi * 16 + fr) * 68 + ni * 16 + 4 * fq) = acc[mi][ni];
}
template <int MT>
__device__ __forceinline__ f32x4 ctx_reduce(const LAS float* part, int row, int c4) {
    f32x4 s = *(const LAS f32x4*)(part + row * 68 + c4);
#pragma unroll
    for (int w = 1; w < 8; ++w) s += *(const LAS f32x4*)(part + w * (MT * 68) + row * 68 + c4);
    return s;
}


template <int W>
__device__ __forceinline__ void pool_lat_item(const bf16_t* XN, bf16_t* Zb, LAS float* ldsf, int b, int r, int gi, int tid) {
    const int rlo = max(r - W / 2, 0), rhi = min(r + W - W / 2, 128);
#pragma unroll 1
    for (int i = 0; i < 4; ++i) { const int e = tid + 512 * i, c = e >> 5, cv = e & 31;
        const bf16_t* src = XN + ((size_t)b * 8192 + c) * D + 256 * gi + 8 * cv;
        u32x4 uu[W];
#pragma unroll
        for (int k = 0; k < W; ++k) { int rr = r - W / 2 + k; rr = rr < 0 ? 0 : (rr > 127 ? 127 : rr); uu[k] = *(const u32x4*)(src + (size_t)rr * 64 * D); }
        float a[8];
#pragma unroll
        for (int q = 0; q < 8; ++q) a[q] = 0.f;
#pragma unroll
        for (int k = 0; k < W; ++k) { const int rr = r - W / 2 + k; const float m = (rr >= 0 && rr < 128) ? 1.0f : 0.0f;
            a[0] += m * bflo(uu[k].x); a[1] += m * bfhi(uu[k].x); a[2] += m * bflo(uu[k].y); a[3] += m * bfhi(uu[k].y);
            a[4] += m * bflo(uu[k].z); a[5] += m * bfhi(uu[k].z); a[6] += m * bflo(uu[k].w); a[7] += m * bfhi(uu[k].w); }
        LAS f32x4* d4 = (LAS f32x4*)(ldsf + c * 256 + 8 * cv);
        d4[0] = (f32x4){a[0], a[1], a[2], a[3]}; d4[1] = (f32x4){a[4], a[5], a[6], a[7]}; }
    __syncthreads();
#pragma unroll 1
    for (int i = 0; i < 4; ++i) { const int e = tid + 512 * i, c = e >> 5, cv = e & 31;
        const u32x4 uc = *(const u32x4*)(XN + ((size_t)b * 8192 + r * 64 + c) * D + 256 * gi + 8 * cv);
        const int clo = max(c - W / 2, 0), chi = min(c + W - W / 2, 64);
        f32x4 t0 = (f32x4){0.f, 0.f, 0.f, 0.f}, t1 = t0;
#pragma unroll
        for (int k = 0; k < W; ++k) { const int cc = c - W / 2 + k; const int ccc = cc < 0 ? 0 : (cc > 63 ? 63 : cc); const float m = (cc >= 0 && cc < 64) ? 1.0f : 0.0f;
            const LAS f32x4* s4 = (const LAS f32x4*)(ldsf + ccc * 256 + 8 * cv); t0 += s4[0] * m; t1 += s4[1] * m; }
        const float inv = 1.0f / (float)((rhi - rlo) * (chi - clo));
        u32x4 wv; wv.x = pk2(t0[0] * inv - bflo(uc.x), t0[1] * inv - bfhi(uc.x)); wv.y = pk2(t0[2] * inv - bflo(uc.y), t0[3] * inv - bfhi(uc.y));
        wv.z = pk2(t1[0] * inv - bflo(uc.z), t1[1] * inv - bfhi(uc.z)); wv.w = pk2(t1[2] * inv - bflo(uc.w), t1[3] * inv - bfhi(uc.w));
        *(u32x4*)(Zb + ((size_t)b * 8192 + r * 64 + c) * D + 256 * gi + 8 * cv) = wv; }
    __syncthreads();
}


template <int W>
__device__ __forceinline__ void pool_band_item(const bf16_t* XN, bf16_t* Zb, LAS float* ldsf, int b, int r0, int gi, int cq, int tid) {
    constexpr int NL = W + 3;
    const int c = tid >> 3, cv = tid & 7, chb = 256 * gi + 64 * cq + 8 * cv;
    const bf16_t* src = XN + ((size_t)b * 8192 + c) * D + chb;
    u32x4 uu[NL];
#pragma unroll
    for (int k = 0; k < NL; ++k) { int rr = r0 - W / 2 + k; rr = rr < 0 ? 0 : (rr > 127 ? 127 : rr); uu[k] = *(const u32x4*)(src + (size_t)rr * 64 * D); }
#pragma unroll
    for (int k = 0; k < NL; ++k) { const int rr = r0 - W / 2 + k; if (rr < 0 || rr > 127) uu[k] = (u32x4){0u, 0u, 0u, 0u}; }
    float vs[8];
#pragma unroll
    for (int q = 0; q < 8; ++q) vs[q] = 0.f;
#pragma unroll
    for (int k = 0; k < W; ++k) { vs[0] += bflo(uu[k].x); vs[1] += bfhi(uu[k].x); vs[2] += bflo(uu[k].y); vs[3] += bfhi(uu[k].y); vs[4] += bflo(uu[k].z); vs[5] += bfhi(uu[k].z); vs[6] += bflo(uu[k].w); vs[7] += bfhi(uu[k].w); }
    const int clo = max(c - W / 2, 0), chi = min(c + W - W / 2, 64);
#pragma unroll
    for (int dr = 0; dr < 4; ++dr) {
        if (dr > 0) { const u32x4 a = uu[W - 1 + dr], o = uu[dr - 1];
            vs[0] += bflo(a.x) - bflo(o.x); vs[1] += bfhi(a.x) - bfhi(o.x); vs[2] += bflo(a.y) - bflo(o.y); vs[3] += bfhi(a.y) - bfhi(o.y);
            vs[4] += bflo(a.z) - bflo(o.z); vs[5] += bfhi(a.z) - bfhi(o.z); vs[6] += bflo(a.w) - bflo(o.w); vs[7] += bfhi(a.w) - bfhi(o.w); }
        LAS float* lbuf = ldsf + (dr & 1) * 4096;
        LAS f32x4* d4 = (LAS f32x4*)(lbuf + c * 64 + 8 * cv);
        d4[0] = (f32x4){vs[0], vs[1], vs[2], vs[3]}; d4[1] = (f32x4){vs[4], vs[5], vs[6], vs[7]};
        __syncthreads();
        const int r = r0 + dr, rlo = max(r - W / 2, 0), rhi = min(r + W - W / 2, 128);
        f32x4 t0 = (f32x4){0.f, 0.f, 0.f, 0.f}, t1 = t0;
#pragma unroll
        for (int k = 0; k < W; ++k) { const int cc = c - W / 2 + k; const int ccc = cc < 0 ? 0 : (cc > 63 ? 63 : cc); const float m = (cc >= 0 && cc < 64) ? 1.0f : 0.0f;
            const LAS f32x4* s4 = (const LAS f32x4*)(lbuf + ccc * 64 + 8 * cv); t0 += s4[0] * m; t1 += s4[1] * m; }
        const float inv = 1.0f / (float)((rhi - rlo) * (chi - clo));
        const u32x4 uc = uu[W / 2 + dr];
        u32x4 wv; wv.x = pk2(t0[0] * inv - bflo(uc.x), t0[1] * inv - bfhi(uc.x)); wv.y = pk2(t0[2] * inv - bflo(uc.y), t0[3] * inv - bfhi(uc.y));
        wv.z = pk2(t1[0] * inv - bflo(uc.z), t1[1] * inv - bfhi(uc.z)); wv.w = pk2(t1[2] * inv - bflo(uc.w), t1[3] * inv - bfhi(uc.w));
        *(u32x4*)(Zb + ((size_t)b * 8192 + r * 64 + c) * D + chb) = wv;
    }
}

__global__ void __launch_bounds__(512, 2) fwd_kernel(Params P) {
    extern __shared__ __attribute__((aligned(16))) unsigned char shm_raw[];
    LAS unsigned char* lds = (LAS unsigned char*)shm_raw;
    LAS float* ldsf = (LAS float*)lds;
    cg::grid_group grid = cg::this_grid();
    const int nb = gridDim.x, bid = blockIdx.x;
#define PHASE_IDS int tid = threadIdx.x; asm volatile("" : "+v"(tid)); const int lane = tid & 63, wave = __builtin_amdgcn_readfirstlane(tid >> 6); (void)lane; (void)wave;
    unsigned char* ws = P.ws;
    bf16_t* W1T = (bf16_t*)(ws + OFF_W1); bf16_t* W2T = (bf16_t*)(ws + OFF_W2); bf16_t* WGT = (bf16_t*)(ws + OFF_WG); bf16_t* WPT = (bf16_t*)(ws + OFF_WP);
    float* MOD = (float*)(ws + OFF_MOD); float* XC = (float*)(ws + OFF_XC);
    bf16_t* XN = (bf16_t*)(ws + OFF_XN); bf16_t* Zb = (bf16_t*)(ws + OFF_Z); bf16_t* ACT = (bf16_t*)(ws + OFF_ACT);
    float* MTAB = (float*)(ws + OFF_MTAB);
    bf16_t* TC = (bf16_t*)(ws + OFF_TC); bf16_t* SM = (bf16_t*)(ws + OFF_SM); float* SL = (float*)(ws + OFF_SL); bf16_t* XS = (bf16_t*)(ws + OFF_XS);
    const XPtr XP{P.out, XC};
    pg8::Sched S;
    volatile LAS unsigned* xb_st = (volatile LAS unsigned*)(lds + LDS_BYTES - 16);
    if (threadIdx.x == 0) { xb_st[0] = 0u; xb_st[1] = 0u; }
    __syncthreads();
    (void)xcd_barrier_post((unsigned*)(ws + OFF_BAR), xb_st);
#define GBAR() do { XcdBarrier xb_; xb_.bar = (unsigned*)(P.ws + OFF_BAR); xb_.x = xb_xcc_id(); xb_.st = (volatile LAS unsigned*)(lds + LDS_BYTES - 16); xcd_barrier(xb_); } while (0)

    {
        PHASE_IDS
        LAS float* scr = (LAS float*)(lds + wave * 8704);
        const int gw = bid * 8 + wave, NGW = nb * 8;
        for (int it = gw; it < 17664; it += NGW) {
            int r = it;
            if (r < 8192) { const int l = r >> 11; transpose_item(P.w1 + (size_t)l * 4194304, 1024, 4096, W1T + (size_t)l * 4194304, scr, r & 2047, lane); continue; }
            r -= 8192;
            if (r < 8192) { const int l = r >> 11; transpose_item(P.w2 + (size_t)l * 4194304, 4096, 1024, W2T + (size_t)l * 4194304, scr, r & 2047, lane); continue; }
            r -= 8192;
            if (r < 1024) { const int jj = r >> 9; transpose_item(P.glu_w + (size_t)jj * 1048576, 1024, 1024, WGT + (size_t)jj * 1048576, scr, r & 511, lane); continue; }
            r -= 1024;
            { const int mm = r >> 5; transpose_item(P.pool_w + (size_t)mm * 65536, 256, 256, WPT + (size_t)mm * 65536, scr, r & 31, lane); }
        }
        __syncthreads();
        LAS float* sv = ldsf;
        LAS float* red = ldsf + 5120;
        for (int i = tid; i < 5120; i += 512) { const int b = i >> 10, k = i & 1023; const float v = b < 4 ? P.c[b * 1024 + k] : P.c_ctx[k]; sv[i] = v * fast_sigmoid(v); }
        __syncthreads();
        for (int pass = bid; pass < 768; pass += nb) {
            const int gcol0 = pass * 32, l = gcol0 / 6144, n0 = gcol0 % 6144, cn = tid & 31, kq = tid >> 5;
            const float* wp = P.ada_w + ((size_t)l * 1024 + kq * 64) * 6144 + n0 + cn;
            float a0 = 0.f, a1 = 0.f, a2 = 0.f, a3 = 0.f, a4 = 0.f;
#pragma unroll 16
            for (int kk = 0; kk < 64; ++kk) { const float w = wp[(size_t)kk * 6144]; const int k = kq * 64 + kk;
                a0 += sv[k] * w; a1 += sv[1024 + k] * w; a2 += sv[2048 + k] * w; a3 += sv[3072 + k] * w; a4 += sv[4096 + k] * w; }
            red[(kq * 5 + 0) * 32 + cn] = a0; red[(kq * 5 + 1) * 32 + cn] = a1; red[(kq * 5 + 2) * 32 + cn] = a2; red[(kq * 5 + 3) * 32 + cn] = a3; red[(kq * 5 + 4) * 32 + cn] = a4;
            __syncthreads();
            if (tid < 160) { const int b = tid >> 5, c2 = tid & 31; float s = P.ada_b[l * 6144 + n0 + c2];
#pragma unroll
                for (int q = 0; q < 16; ++q) s += red[(q * 5 + b) * 32 + c2];
                MOD[(size_t)(l * 5 + b) * 6144 + n0 + c2] = s; }
            __syncthreads();
        }
        LAS float* Bbr = ldsf;
        LAS float* Bbi = ldsf + 1024;
        LAS float* Ctr = ldsf + 2048;
        LAS float* Cti = ldsf + 3072;
        LAS float* pwr = ldsf + 4096;
        LAS float* pwi = ldsf + 4096 + 2112;
        for (int item = bid; item < 256; item += nb) {
            const int dir = item & 1, g = (item >> 1) & 63, j = item >> 7;
            if (tid < 64) { const int p = tid; float dar, dai, kr, ki; s5_disc(P, j, dir, g, p, dar, dai, kr, ki);
                for (int k = 0; k < 32; ++k) { float re, im; cpowk(dar, dai, k, re, im); pwr[p * 33 + k] = re; pwi[p * 33 + k] = im; }
                const size_t bb = ((size_t)((j * 2 + dir) * 64 + g) * 64 + p) * 16;
#pragma unroll
                for (int h = 0; h < 16; ++h) { const float br = P.b_re[bb + h], bi2 = P.b_im[bb + h]; Bbr[p * 16 + h] = kr * br - ki * bi2; Bbi[p * 16 + h] = kr * bi2 + ki * br; } }
            for (int e = tid; e < 1024; e += 512) { const int ho = e >> 6, p = e & 63; const size_t ci = ((size_t)((j * 2 + dir) * 64 + g) * 16 + ho) * 64 + p;
                Ctr[p * 16 + ho] = P.c_re[ci]; Cti[p * 16 + ho] = P.c_im[ci]; }
            __syncthreads();
            { const int k = tid >> 4, ho = tid & 15; float a[16];
#pragma unroll
                for (int h = 0; h < 16; ++h) a[h] = 0.f;
                for (int p = 0; p < 64; ++p) { const float cr = Ctr[p * 16 + ho], ci = Cti[p * 16 + ho], pr = pwr[p * 33 + k], pi = pwi[p * 33 + k];
                    const float cpr = cr * pr - ci * pi, cpi = cr * pi + ci * pr;
                    const LAS f32x4* br4 = (const LAS f32x4*)(Bbr + p * 16); const LAS f32x4* bi4 = (const LAS f32x4*)(Bbi + p * 16);
#pragma unroll
                    for (int q = 0; q < 4; ++q) { const f32x4 br = br4[q], bi2 = bi4[q];
#pragma unroll
                        for (int e = 0; e < 4; ++e) a[q * 4 + e] += cpr * br[e] - cpi * bi2[e]; } }
                float* mo = MTAB + ((size_t)((j * 64 + g) * 2 + dir) * 32 + k) * 256 + ho * 16;
#pragma unroll
                for (int q = 0; q < 4; ++q) ((f32x4*)mo)[q] = (f32x4){a[q * 4], a[q * 4 + 1], a[q * 4 + 2], a[q * 4 + 3]}; }
            __syncthreads();
        }
    }
    if (P.ws == nullptr) grid.sync();
    GBAR();

#pragma unroll 1
    for (int l = 0; l < 4; ++l) {
        const int j = l >> 1;
        const bool ctx_out = l < 2;
        const float* modl = MOD + (size_t)l * 5 * 6144;
        if ((l & 1) == 0) {
            {
                PHASE_IDS
                LAS float* Bbr = ldsf;
                LAS float* Bbi = ldsf + 2048;
                LAS float* Cr = ldsf + 4096;
                LAS float* Ci = ldsf + 6144;
                LAS float* pwr = ldsf + 8192;
                LAS float* pwi = ldsf + 8192 + 4224;
                const int nit = (256 + CRR - bid + nb - 1) / nb;
                for (int kq = 0; kq < nit; ++kq) {
                    const int kk = (bid & 1) ? (kq + 1 == nit ? 0 : kq + 1) : kq; const int item = bid + kk * nb;
                    if (item < 256) {
                        const int g = item >> 2, q4 = item & 3;
                        if (tid < 128) { const int dir = tid >> 6, p = tid & 63; float dar, dai, kr, ki; s5_disc(P, j, dir, g, p, dar, dai, kr, ki);
                            for (int k = 0; k < 33; ++k) { float re, im; cpowk(dar, dai, k, re, im); pwr[(dir * 33 + k) * 64 + p] = re; pwi[(dir * 33 + k) * 64 + p] = im; }
                            const size_t bb = ((size_t)((j * 2 + dir) * 64 + g) * 64 + p) * 16;
#pragma unroll
                            for (int h = 0; h < 16; ++h) { const float br = P.b_re[bb + h], bi2 = P.b_im[bb + h]; Bbr[(dir * 64 + p) * 16 + h] = kr * br - ki * bi2; Bbi[(dir * 64 + p) * 16 + h] = kr * bi2 + ki * br; } }
                        for (int e = tid; e < 2048; e += 512) { const int dir = e >> 10, r2 = e & 1023; const size_t ci = (size_t)((j * 2 + dir) * 64 + g) * 1024 + r2;
                            Cr[e] = P.c_re[ci]; Ci[e] = P.c_im[ci]; }
                        LAS float* Ml = ldsf + 16640;
                        { const f32x4* msrc = (const f32x4*)(MTAB + (size_t)((j * 64 + g) * 2 + 0) * 8192);
#pragma unroll
                            for (int q = 0; q < 8; ++q) { const int e = tid + 512 * q; *(LAS f32x4*)(Ml + (e >> 6) * 260 + (e & 63) * 4) = msrc[e]; } }
                        __syncthreads();
                        const LAS float* Mf = Ml; const LAS float* Mb = Ml + 32 * 260;
                        const float dsk_ho_base = 0.f; (void)dsk_ho_base;
                        for (int e = tid; e < 12288; e += 512) { const int nl = e / 96, kv = e % 96, n = 128 * q4 + nl, t = n >> 4, ho = n & 15, k0 = kv * 8;
                            float v[8];
                            if (k0 < 512) { const int s = k0 >> 4, hi0 = k0 & 15;
#pragma unroll
                                for (int i = 0; i < 8; ++i) v[i] = 0.f;
                                if (t >= s) { const f32x4 m0 = *(const LAS f32x4*)(Mf + (t - s) * 260 + ho * 16 + hi0), m1 = *(const LAS f32x4*)(Mf + (t - s) * 260 + ho * 16 + hi0 + 4);
#pragma unroll
                                    for (int i = 0; i < 4; ++i) { v[i] += m0[i]; v[4 + i] += m1[i]; } }
                                if (s >= t) { const f32x4 m0 = *(const LAS f32x4*)(Mb + (s - t) * 260 + ho * 16 + hi0), m1 = *(const LAS f32x4*)(Mb + (s - t) * 260 + ho * 16 + hi0 + 4);
#pragma unroll
                                    for (int i = 0; i < 4; ++i) { v[i] += m0[i]; v[4 + i] += m1[i]; } }
                                if (s == t) { const float dsk = P.s5_d[j * 1024 + 16 * g + ho];
#pragma unroll
                                    for (int i = 0; i < 8; ++i) v[i] += (hi0 + i == ho) ? dsk : 0.f; }
                            } else { const int q = k0 - 512, dir = q >> 7, part = (q >> 6) & 1, p0 = q & 63, ee = dir ? 32 - t : t + 1;
#pragma unroll
                                for (int i = 0; i < 8; ++i) { const int p = p0 + i; const float cr = Cr[(dir * 16 + ho) * 64 + p], ci = Ci[(dir * 16 + ho) * 64 + p], pr = pwr[(dir * 33 + ee) * 64 + p], pi = pwi[(dir * 33 + ee) * 64 + p];
                                    v[i] = part ? -(cr * pi + ci * pr) : (cr * pr - ci * pi); } }
                            u32x4 w; w.x = pk2(v[0], v[1]); w.y = pk2(v[2], v[3]); w.z = pk2(v[4], v[5]); w.w = pk2(v[6], v[7]);
                            *(u32x4*)(TC + ((size_t)g * 512 + n) * XS_K + k0) = w; }
                        for (int e = tid; e < 4096; e += 512) { const int ql = e >> 6, kv = e & 63, q = 64 * q4 + ql, dir = q >> 7, part = (q >> 6) & 1, p = q & 63, k0 = kv * 8, s = k0 >> 4, hi0 = k0 & 15, ee = dir ? s : 31 - s;
                            const float pr = pwr[(dir * 33 + ee) * 64 + p], pi = pwi[(dir * 33 + ee) * 64 + p];
                            float v[8];
#pragma unroll
                            for (int i = 0; i < 8; ++i) { const float br = Bbr[(dir * 64 + p) * 16 + hi0 + i], bi2 = Bbi[(dir * 64 + p) * 16 + hi0 + i]; v[i] = part ? (pr * bi2 + pi * br) : (pr * br - pi * bi2); }
                            u32x4 w; w.x = pk2(v[0], v[1]); w.y = pk2(v[2], v[3]); w.z = pk2(v[4], v[5]); w.w = pk2(v[6], v[7]);
                            *(u32x4*)(SM + ((size_t)g * 256 + q) * 512 + k0) = w; }
                        __syncthreads();
                    } else {
                        const int cr = item - 256; const int bi = cr < 1024 ? (cr >> 8) : 4;
                        const int row0 = cr < 1024 ? (cr >> 8) * 8192 + (cr & 255) * 32 : NLAT + (cr - 1024) * 32;
                        const float* gam = P.norm1_g + l * 1024 + 16 * lane; const float* shp = modl + bi * 6144 + 16 * lane; const float* scp = shp + 1024;
                        f32x4 gs[4], sh[4];
#pragma unroll
                        for (int q = 0; q < 4; ++q) { gs[q] = ((const f32x4*)gam)[q] * (((const f32x4*)scp)[q] + 1.0f); sh[q] = ((const f32x4*)shp)[q]; }
                        {
                            f32x4 v[4][4]; float ss[4];
#pragma unroll
                            for (int r = 0; r < 4; ++r) { const int row = row0 + wave + 8 * r;
                                const float* src = (l == 0) ? (row < NLAT ? P.x + (size_t)row * D : P.ctx + (size_t)(row - NLAT) * D) : (row < NLAT ? P.out + (size_t)row * D : XC + (size_t)(row - NLAT) * D);
#pragma unroll
                                for (int q = 0; q < 4; ++q) v[r][q] = ((const f32x4*)(src + 16 * lane))[q]; }
                            __builtin_amdgcn_sched_barrier(0);
#pragma unroll
                            for (int r = 0; r < 4; ++r) { ss[r] = 0.f;
#pragma unroll
                                for (int q = 0; q < 4; ++q) ss[r] += (v[r][q][0] * v[r][q][0] + v[r][q][1] * v[r][q][1]) + (v[r][q][2] * v[r][q][2] + v[r][q][3] * v[r][q][3]); }
#pragma unroll
                            for (int r = 0; r < 4; ++r) { const int t = wave + 8 * r;
                                const float rstd = rsqrtf(wave_sum(ss[r]) * (1.0f / D) + 1e-6f);
                                u32x4 w0, w1; f32x4 o;
                                o = v[r][0] * rstd * gs[0] + sh[0]; w0.x = pk2(o[0], o[1]); w0.y = pk2(o[2], o[3]);
                                o = v[r][1] * rstd * gs[1] + sh[1]; w0.z = pk2(o[0], o[1]); w0.w = pk2(o[2], o[3]);
                                o = v[r][2] * rstd * gs[2] + sh[2]; w1.x = pk2(o[0], o[1]); w1.y = pk2(o[2], o[3]);
                                o = v[r][3] * rstd * gs[3] + sh[3]; w1.z = pk2(o[0], o[1]); w1.w = pk2(o[2], o[3]);
                                LAS u32x4* dq = (LAS u32x4*)(lds + lane * 1040 + t * 32);
                                dq[0] = w0; dq[1] = w1; } }
                        __syncthreads();
#pragma unroll
                        for (int gq = 0; gq < 8; ++gq) { const int g = wave * 8 + gq;
                            const u32x4 w = *(const LAS u32x4*)(lds + g * 1040 + lane * 16);
                            *(u32x4*)(XS + ((size_t)g * CRR + cr) * XS_K + lane * 8) = w; }
                        __syncthreads();
                    }
                }
            }
            GBAR();
            { pg8::Gemm gm{XS, SM, XS_K, 512, (long)CRR * XS_K, 256L * 512, 0}; S.init(4, 1, 64, nb, bid, 1); EpiG1 E{SL}; pg8::gemm_phase(lds, gm, S, E); }
            { PHASE_IDS
                for (int item = bid; item < 256; item += nb) { const int g = item >> 2, q = item & 3;
                    ctx_tile<32, 512>(ldsf, XS + ((size_t)g * CRR + 1024) * XS_K, XS_K, SM + ((size_t)g * 256 + q * 64) * 512, 512, tid);
                    __syncthreads();
                    { const int row = tid >> 4, c4 = (tid & 15) * 4; const f32x4 v = ctx_reduce<32>(ldsf, row, c4);
                        *(f32x4*)(SL + ((size_t)g * CR_PAD + 1024 + row) * 256 + q * 64 + c4) = v; }
                    __syncthreads(); } }
            GBAR();
            {
                PHASE_IDS
                LAS float* er = ldsf; LAS float* ei = ldsf + 512;
                for (int item = bid; item < 512; item += nb) {
                    const int dir = item & 1, g = (item >> 1) & 63, b = item >> 7, p = lane, seg = wave;
                    float dar, dai, kr, ki; s5_disc(P, j, dir, g, p, dar, dai, kr, ki);
                    float Ar, Ai, A33r, A33i; cpowk(dar, dai, 32, Ar, Ai); cpowk(dar, dai, 32 * 33, A33r, A33i);
                    const float* sl = SL + (size_t)g * CR_PAD * 256 + dir * 128 + p;
                    float vr[33], vi[33];
#pragma unroll
                    for (int jj = 0; jj < 33; ++jj) { const int i = seg * 33 + jj; const int cr = i < 8 ? 1024 + b * 8 + (dir ? 7 - i : i) : b * 256 + (dir ? 263 - i : i - 8);
                        vr[jj] = sl[(size_t)cr * 256]; vi[jj] = sl[(size_t)cr * 256 + 64]; }
#pragma unroll
                    for (int jj = 1; jj < 33; ++jj) { const float nr = Ar * vr[jj - 1] - Ai * vi[jj - 1] + vr[jj], ni = Ar * vi[jj - 1] + Ai * vr[jj - 1] + vi[jj]; vr[jj] = nr; vi[jj] = ni; }
                    er[seg * 64 + p] = vr[32]; ei[seg * 64 + p] = vi[32];
                    __syncthreads();
                    float cr_ = 0.f, ci_ = 0.f;
                    for (int s2 = 0; s2 < seg; ++s2) { const float nr = A33r * cr_ - A33i * ci_ + er[s2 * 64 + p], ni = A33r * ci_ + A33i * cr_ + ei[s2 * 64 + p]; cr_ = nr; ci_ = ni; }
                    __syncthreads();
                    bf16_t* xo = XS + (size_t)g * CRR * XS_K + 512 + dir * 128 + p;
#pragma unroll
                    for (int jj = 0; jj < 33; ++jj) { const int i = seg * 33 + jj; const int cr = i < 8 ? 1024 + b * 8 + (dir ? 7 - i : i) : b * 256 + (dir ? 263 - i : i - 8);
                        const float orr = jj == 0 ? cr_ : vr[jj - 1] + cr_, oi = jj == 0 ? ci_ : vi[jj - 1] + ci_;
                        const unsigned w = pk2(orr, oi);
                        xo[(size_t)cr * XS_K] = (bf16_t)(w & 0xffffu); xo[(size_t)cr * XS_K + 64] = (bf16_t)(w >> 16);
                        const float nr = Ar * cr_ - Ai * ci_, ni = Ar * ci_ + Ai * cr_; cr_ = nr; ci_ = ni; }
                }
            }
            GBAR();
            { pg8::Gemm gm{XS, TC, XS_K, XS_K, (long)CRR * XS_K, 512L * XS_K, 0}; S.init(4, 2, 64, nb, bid, 1); EpiG2 E{Zb, XS, P.s5_d + j * 1024}; pg8::gemm_phase(lds, gm, S, E); }
            if (ctx_out) { PHASE_IDS
                for (int item = bid; item < 512; item += nb) { const int g = item >> 3, q = item & 7;
                    ctx_tile<32, 768>(ldsf, XS + ((size_t)g * CRR + 1024) * XS_K, XS_K, TC + ((size_t)g * 512 + q * 64) * XS_K, XS_K, tid);
                    __syncthreads();
                    { const int row = tid >> 4, c4 = (tid & 15) * 4; f32x4 v = ctx_reduce<32>(ldsf, row, c4);
                        const int n = q * 64 + c4, t = n >> 4, ho = n & 15, ch = 16 * g + ho;
                        v[0] = gelu_tanh(v[0]); v[1] = gelu_tanh(v[1]); v[2] = gelu_tanh(v[2]); v[3] = gelu_tanh(v[3]);
                        u32x2 w; w.x = pk2(v[0], v[1]); w.y = pk2(v[2], v[3]);
                        *(u32x2*)(Zb + ((size_t)g * NROW + NLAT + row * 32 + t) * 16 + ho) = w; }
                    __syncthreads(); } }
            GBAR();
            { pg8::Gemm gm{Zb, WGT + (size_t)j * 1048576, 1024, 1024, 0, 0, NROW}; S.init(128, 4, 1, nb, bid); EpiGLU E{XP, Zb, P.glu_b + j * 1024, modl,  1.0f, l == 0 ? P.x : P.out}; pg8::gemm_phase(lds, gm, S, E); }
            if (ctx_out) { PHASE_IDS
                const float gsc =  1.0f;
                for (int item = bid; item < 256; item += nb) { const int rb = ((item & 7) >> 1) * 4 + ((item >> 3) & 3), cb = (item & 1) * 8 + (item >> 5);
                    ctx_tile<64, 1024>(ldsf, Zb + ((size_t)NLAT + rb * 64) * 16, D, WGT + (size_t)j * 1048576 + (size_t)cb * 64 * 1024, 1024, tid, NROW);
                    __syncthreads();
#pragma unroll
                    for (int h = 0; h < 2; ++h) { const int e = tid + 512 * h, row = e >> 4, c4 = (e & 15) * 4, col = cb * 64 + c4; const f32x4 a = ctx_reduce<64>(ldsf, row, c4) + *(const f32x4*)(P.glu_b + j * 1024 + col);
                        const u32x2 zz = *(const u32x2*)(Zb + ((size_t)(col >> 4) * NROW + NLAT + rb * 64 + row) * 16 + (col & 15));
                        f32x4 y; y[0] = bflo(zz.x) * fast_sigmoid(a[0]); y[1] = bfhi(zz.x) * fast_sigmoid(a[1]); y[2] = bflo(zz.y) * fast_sigmoid(a[2]); y[3] = bfhi(zz.y) * fast_sigmoid(a[3]);
                        f32x4* xq = (f32x4*)(XC + (size_t)(rb * 64 + row) * D + col);
                        const f32x4 xv = *(const f32x4*)((l == 0 ? P.ctx : XC) + (size_t)(rb * 64 + row) * D + col);
                        *xq = xv + *(const f32x4*)(modl + 4 * 6144 + 2048 + col) * gsc * y; }
                    __syncthreads(); } }
            GBAR();
        } else {
            { PHASE_IDS
                const int nrows = ctx_out ? NROW : NLAT;
                for (int row = bid * 8 + wave; row < nrows; row += nb * 16) { const int rw1 = (row + nb * 8 < nrows) ? row + nb * 8 : row;
                    const int bi0 = row < NLAT ? (row >> 13) : 4, bi1 = rw1 < NLAT ? (rw1 >> 13) : 4;
                    const float* xr0 = row < NLAT ? P.out + (size_t)row * D : XC + (size_t)(row - NLAT) * D;
                    const float* xr1 = rw1 < NLAT ? P.out + (size_t)rw1 * D : XC + (size_t)(rw1 - NLAT) * D;
                    norm_rows2_tm(xr0, xr1, P.norm1_g + l * 1024, modl + bi0 * 6144, modl + bi1 * 6144, XN + (size_t)row * D, XN + (size_t)rw1 * D, lane); } }
            GBAR();
            {
                PHASE_IDS
                const int nitems = 2048 + (ctx_out ? 256 : 0);
                for (int item = bid; item < nitems; item += nb) {
                    if (item < 2048) {
                        const int rest = item >> 2, gi = ((item & 3) + (item >> 8)) & 3, cq = rest & 3, r0 = ((rest >> 2) & 31) * 4, b = rest >> 7;
                        if (gi == 0) pool_band_item<2>(XN, Zb, ldsf, b, r0, gi, cq, tid);
                        else if (gi == 1) pool_band_item<4>(XN, Zb, ldsf, b, r0, gi, cq, tid);
                        else if (gi == 2) pool_band_item<8>(XN, Zb, ldsf, b, r0, gi, cq, tid);
                        else pool_band_item<16>(XN, Zb, ldsf, b, r0, gi, cq, tid);
                    } else {
                        const int ci = item - 2048, gi = ci & 3, tb = (ci >> 2) & 15, b = ci >> 6, w = 2 << gi;
                        const int t = tb * 16 + (tid >> 5), cv = tid & 31;
                        const int lo = max(t - (w >> 1), 0), hi = min(t + w - (w >> 1), 256);
                        float a[8], cen[8];
#pragma unroll
                        for (int q = 0; q < 8; ++q) a[q] = 0.f;
                        const bf16_t* src = XN + ((size_t)NLAT + b * 256) * D + 256 * gi + 8 * cv;
                        for (int tt = lo; tt < hi; ++tt) { const u32x4 uu = *(const u32x4*)(src + (size_t)tt * D);
                            const float f0 = bflo(uu.x), f1 = bfhi(uu.x), f2 = bflo(uu.y), f3 = bfhi(uu.y), f4 = bflo(uu.z), f5 = bfhi(uu.z), f6 = bflo(uu.w), f7 = bfhi(uu.w);
                            a[0] += f0; a[1] += f1; a[2] += f2; a[3] += f3; a[4] += f4; a[5] += f5; a[6] += f6; a[7] += f7; }
                        { const u32x4 uu = *(const u32x4*)(src + (size_t)t * D);
                            cen[0] = bflo(uu.x); cen[1] = bfhi(uu.x); cen[2] = bflo(uu.y); cen[3] = bfhi(uu.y); cen[4] = bflo(uu.z); cen[5] = bfhi(uu.z); cen[6] = bflo(uu.w); cen[7] = bfhi(uu.w); }
                        const float inv = 1.0f / (float)(hi - lo);
                        u32x4 wv; wv.x = pk2(a[0] * inv - cen[0], a[1] * inv - cen[1]); wv.y = pk2(a[2] * inv - cen[2], a[3] * inv - cen[3]);
                        wv.z = pk2(a[4] * inv - cen[4], a[5] * inv - cen[5]); wv.w = pk2(a[6] * inv - cen[6], a[7] * inv - cen[7]);
                        *(u32x4*)(Zb + ((size_t)NLAT + b * 256 + t) * D + 256 * gi + 8 * cv) = wv;
                    }
                }
            }
            GBAR();
            { pg8::Gemm gm{Zb, WPT + (size_t)j * 262144, 1024, 256, 256, 65536, 0}; S.init(128, 1, 4, nb, bid); EpiPool E{XP, P.pool_scale + j * 1024, modl,  1.0f}; pg8::gemm_phase(lds, gm, S, E); }
            if (ctx_out) { PHASE_IDS
                const float gsc =  1.0f;
                for (int item = bid; item < 256; item += nb) { const int rb = ((item & 7) >> 1) * 4 + ((item >> 3) & 3), cb = (item & 1) * 8 + (item >> 5), gi = cb >> 2;
                    ctx_tile<64, 256>(ldsf, Zb + ((size_t)NLAT + rb * 64) * D + gi * 256, D, WPT + (size_t)j * 262144 + (size_t)gi * 65536 + (size_t)(cb & 3) * 64 * 256, 256, tid);
                    __syncthreads();
#pragma unroll
                    for (int h = 0; h < 2; ++h) { const int e = tid + 512 * h, row = e >> 4, c4 = (e & 15) * 4, col = cb * 64 + c4; const f32x4 a = ctx_reduce<64>(ldsf, row, c4);
                        f32x4* xq = (f32x4*)(XC + (size_t)(rb * 64 + row) * D + col);
                        *xq = *xq + *(const f32x4*)(modl + 4 * 6144 + 2048 + col) * *(const f32x4*)(P.pool_scale + j * 1024 + col) * gsc * a; }
                    __syncthreads(); } }
            GBAR();
        }
        { PHASE_IDS
            const int nrows = ctx_out ? NROW : NLAT;
            for (int row = bid * 8 + wave; row < nrows; row += nb * 16) { const int rw1 = (row + nb * 8 < nrows) ? row + nb * 8 : row;
                const int bi0 = row < NLAT ? (row >> 13) : 4, bi1 = rw1 < NLAT ? (rw1 >> 13) : 4;
                const float* xr0 = row < NLAT ? P.out + (size_t)row * D : XC + (size_t)(row - NLAT) * D;
                const float* xr1 = rw1 < NLAT ? P.out + (size_t)rw1 * D : XC + (size_t)(rw1 - NLAT) * D;
                norm_rows2_tm(xr0, xr1, P.norm2_g + l * 1024, modl + bi0 * 6144 + 3072, modl + bi1 * 6144 + 3072, XN + (size_t)row * D, XN + (size_t)rw1 * D, lane); } }
        GBAR();
        { pg8::Gemm gm{XN, W1T + (size_t)l * 4194304, 1024, 1024, 0, 0, 0}; S.init(128, 16, 1, nb, bid); EpiM1 E{ACT, P.b1 + l * 4096}; pg8::gemm_phase(lds, gm, S, E); }
        if (ctx_out) { PHASE_IDS
            for (int item = bid; item < 256; item += nb) { const int rb = item >> 4, cb = item & 15;
#pragma unroll 1
                for (int sub = 0; sub < 4; ++sub) { const int n0 = cb * 256 + sub * 64;
                    ctx_tile<64, 1024>(ldsf, XN + ((size_t)NLAT + rb * 64) * D, D, W1T + (size_t)l * 4194304 + (size_t)n0 * 1024, 1024, tid);
                    __syncthreads();
#pragma unroll
                    for (int h = 0; h < 2; ++h) { const int e = tid + 512 * h, row = e >> 4, c4 = (e & 15) * 4, col = n0 + c4; f32x4 a = ctx_reduce<64>(ldsf, row, c4) + *(const f32x4*)(P.b1 + l * 4096 + col);
#pragma unroll
                        for (int q = 0; q < 4; ++q) { const float r = fmaxf(a[q], 0.f); a[q] = r * r; }
                        u32x2 w; w.x = pk2(a[0], a[1]); w.y = pk2(a[2], a[3]);
                        *(u32x2*)(ACT + ((size_t)NLAT + rb * 64 + row) * DFF + col) = w; }
                    __syncthreads(); } } }
        GBAR();
        { pg8::Gemm gm{ACT, W2T + (size_t)l * 4194304, 4096, 4096, 0, 0, 0}; S.init(128, 4, 1, nb, bid); EpiM2 E{XP, P.b2 + l * 1024, modl,  1.0f}; pg8::gemm_phase(lds, gm, S, E); }
        if (ctx_out) { PHASE_IDS
            const float gsc =  1.0f;
            for (int item = bid; item < 256; item += nb) { const int rb = ((item & 7) >> 1) * 4 + ((item >> 3) & 3), cb = (item & 1) * 8 + (item >> 5);
                ctx_tile<64, 4096>(ldsf, ACT + ((size_t)NLAT + rb * 64) * DFF, DFF, W2T + (size_t)l * 4194304 + (size_t)cb * 64 * 4096, 4096, tid);
                __syncthreads();
#pragma unroll
                for (int h = 0; h < 2; ++h) { const int e = tid + 512 * h, row = e >> 4, c4 = (e & 15) * 4, col = cb * 64 + c4; const f32x4 a = ctx_reduce<64>(ldsf, row, c4) + *(const f32x4*)(P.b2 + l * 1024 + col);
                    f32x4* xq = (f32x4*)(XC + (size_t)(rb * 64 + row) * D + col);
                    *xq = *xq + *(const f32x4*)(modl + 4 * 6144 + 5120 + col) * gsc * a; }
                __syncthreads(); } }
        GBAR();
    }
    { PHASE_IDS
    for (int row = bid * 8 + wave; row < NLAT; row += nb * 16) {
        const int rw1 = (row + nb * 8 < NLAT) ? row + nb * 8 : row;
        float* xr0 = P.out + (size_t)row * D; float* xr1 = P.out + (size_t)rw1 * D;
        f32x4 v0[4], v1[4]; float s0 = 0.f, s1 = 0.f;
#pragma unroll
        for (int q = 0; q < 4; ++q) { v0[q] = ((const f32x4*)xr0)[lane + 64 * q]; v1[q] = ((const f32x4*)xr1)[lane + 64 * q]; }
        f32x4 fgv[4];
#pragma unroll
        for (int q = 0; q < 4; ++q) fgv[q] = ((const f32x4*)P.final_g)[lane + 64 * q];
        __builtin_amdgcn_sched_barrier(0);
#pragma unroll
        for (int q = 0; q < 4; ++q) { s0 += (v0[q][0] * v0[q][0] + v0[q][1] * v0[q][1]) + (v0[q][2] * v0[q][2] + v0[q][3] * v0[q][3]);
            s1 += (v1[q][0] * v1[q][0] + v1[q][1] * v1[q][1]) + (v1[q][2] * v1[q][2] + v1[q][3] * v1[q][3]); }
        const float r0 = rsqrtf(wave_sum(s0) * (1.0f / D) + 1e-6f), r1 = rsqrtf(wave_sum(s1) * (1.0f / D) + 1e-6f);
#pragma unroll
        for (int q = 0; q < 4; ++q) { const f32x4 fg = fgv[q];
            ((f32x4*)xr0)[lane + 64 * q] = v0[q] * r0 * fg; if (rw1 != row) ((f32x4*)xr1)[lane + 64 * q] = v1[q] * r1 * fg; }
    } }
}

extern "C" void kernel_launch(void* const* d_in, const int* in_sizes, int n_in, void* d_out, int out_size, void* d_ws, size_t ws_size, hipStream_t stream) {
    static int grid_blocks = 0;
    if (grid_blocks == 0) {
        if (n_in != 25 || out_size != NLAT * D || ws_size < WS_END) { fprintf(stderr, "kernel_launch: unexpected shapes (n_in %d out %d ws %zu need %zu)\n", n_in, out_size, ws_size, (size_t)WS_END); grid_blocks = -1; return; }
        int dev = 0, cus = 0, per_cu = 0;
        hipGetDevice(&dev);
        hipDeviceGetAttribute(&cus, hipDeviceAttributeMultiprocessorCount, dev);
        if (hipFuncSetAttribute((const void*)fwd_kernel, hipFuncAttributeMaxDynamicSharedMemorySize, LDS_BYTES) != hipSuccess) { fprintf(stderr, "kernel_launch: hipFuncSetAttribute failed\n"); grid_blocks = -1; return; }
        hipOccupancyMaxActiveBlocksPerMultiprocessor(&per_cu, (const void*)fwd_kernel, 512, LDS_BYTES);
        if (per_cu < 1) per_cu = 1;
        grid_blocks = cus * per_cu;
    }
    if (grid_blocks < 0) return;
    Params P{};
    const float** pp = (const float**)&P;
    for (int i = 0; i < 25; ++i) pp[i] = (const float*)d_in[i];
    P.out = (float*)d_out; P.ws = (unsigned char*)d_ws;
    if (hipMemsetAsync((char*)d_ws + OFF_BAR, 0, 16384, stream) != hipSuccess) { fprintf(stderr, "kernel_launch: memset of barrier words failed\n"); return; }
    void* args[] = {&P};
    hipError_t e = hipLaunchCooperativeKernel((const void*)fwd_kernel, dim3(grid_blocks), dim3(512), args, LDS_BYTES, stream);
    if (e != hipSuccess) fprintf(stderr, "cooperative launch failed: %s (grid %d)\n", hipGetErrorString(e), grid_blocks);
}
```
